# Optimizing an MI355X kernel written in HIP

```python
import jax, jax.numpy as jnp
from jax import lax
import numpy as np

D_MODEL = 1024
BATCH = 8
SEQ = 8192
DEPTH = 2

N_MIXERS = 2
MLA_HEADS = 8
MLA_Q_LORA = 256
MLA_KV_LORA = 256
MLA_NOPE = 128
MLA_ROPE = 64
MLA_V = 128
ROPE_THETA = 10000.0
Q_BLOCK = 128
HGRN_HEADS = 8
HGRN_DK = D_MODEL // HGRN_HEADS
HGRN_DV = D_MODEL // HGRN_HEADS
HGRN_CHUNK = 64
D_FF = ((8 * D_MODEL // 3 + 255) // 256) * 256
D_PLE = 256
LN_EPS = 1e-5
RMS_EPS = 1e-6
DEEPNORM_ALPHA = (2 * DEPTH) ** 0.25
DEEPNORM_BETA = (8 * DEPTH) ** -0.25
N_MLA_LAYERS = (DEPTH + N_MIXERS - 1) // N_MIXERS
N_HGRN_LAYERS = DEPTH // N_MIXERS

kernel_name = 'hybrid_mla_hgrn2_deepnorm_ple'


def layer_norm(x, g, b):
    xf = x.astype(jnp.float32)
    mu = jnp.mean(xf, axis=-1, keepdims=True)
    var = jnp.mean(jnp.square(xf - mu), axis=-1, keepdims=True)
    y = (xf - mu) * lax.rsqrt(var + LN_EPS) * g.astype(jnp.float32) + b.astype(jnp.float32)
    return y.astype(x.dtype)


def rms_norm(x, g):
    xf = x.astype(jnp.float32)
    y = xf * lax.rsqrt(jnp.mean(jnp.square(xf), axis=-1, keepdims=True) + RMS_EPS) * g.astype(jnp.float32)
    return y.astype(x.dtype)


def rope_tables(positions):
    inv_freq = ROPE_THETA ** (-jnp.arange(0, MLA_ROPE, 2, dtype=jnp.float32) / MLA_ROPE)
    ang = positions.astype(jnp.float32)[..., None] * inv_freq
    return jnp.cos(ang), jnp.sin(ang)


def apply_rope(t, cos, sin):
    half = t.shape[-1] // 2
    t1, t2 = t[..., :half], t[..., half:]
    out = jnp.concatenate([t1 * cos - t2 * sin, t2 * cos + t1 * sin], axis=-1)
    return out.astype(t.dtype)


def mla_mixer(x, cos, sin, w_dqkv, q_norm, kv_norm, w_uq, w_ukv, w_o):
    B, S, _ = x.shape
    H = MLA_HEADS
    down = x @ w_dqkv
    c_q = rms_norm(down[..., :MLA_Q_LORA], q_norm)
    c_kv = rms_norm(down[..., MLA_Q_LORA:MLA_Q_LORA + MLA_KV_LORA], kv_norm)
    k_rope = apply_rope(down[..., MLA_Q_LORA + MLA_KV_LORA:], cos, sin)
    q = (c_q @ w_uq).reshape(B, S, H, MLA_NOPE + MLA_ROPE)
    q_nope = q[..., :MLA_NOPE]
    q_rope = apply_rope(q[..., MLA_NOPE:], cos[:, :, None, :], sin[:, :, None, :])
    kv = (c_kv @ w_ukv).reshape(B, S, H, MLA_NOPE + MLA_V)
    k_nope, v = kv[..., :MLA_NOPE], kv[..., MLA_NOPE:]

    nblk = S // Q_BLOCK
    scale = (MLA_NOPE + MLA_ROPE) ** -0.5
    kpos = jnp.arange(S, dtype=jnp.int32)
    qpos = kpos.reshape(nblk, Q_BLOCK)

    def to_blocks(t):
        return jnp.moveaxis(t.reshape((B, nblk, Q_BLOCK) + t.shape[2:]), 1, 0)

    def attend(blk):
        qn, qr, qp = blk
        s = (jnp.einsum('bqhd,bkhd->bhqk', qn, k_nope)
             + jnp.einsum('bqhr,bkr->bhqk', qr, k_rope)).astype(jnp.float32) * scale
        s = jnp.where(kpos[None, None, None, :] <= qp[None, None, :, None], s, -jnp.inf)
        w = jax.nn.softmax(s, axis=-1).astype(v.dtype)
        return jnp.einsum('bhqk,bkhd->bqhd', w, v)

    o = lax.map(attend, (to_blocks(q_nope), to_blocks(q_rope), qpos))
    o = jnp.moveaxis(o, 0, 1).reshape(B, S, H * MLA_V)
    return o @ w_o


def hgrn2_mixer(x, lb, w_in, out_norm, w_o):
    B, S, _ = x.shape
    H, DK, DV, C = HGRN_HEADS, HGRN_DK, HGRN_DV, HGRN_CHUNK
    proj = x @ w_in
    q = jax.nn.silu(proj[..., :H * DK].astype(jnp.float32)).reshape(B, S, H, DK)
    f = proj[..., H * DK:2 * H * DK].astype(jnp.float32).reshape(B, S, H, DK)
    v = proj[..., 2 * H * DK:2 * H * DK + H * DV].astype(jnp.float32).reshape(B, S, H, DV)
    gate = proj[..., 2 * H * DK + H * DV:]
    lb = lb.reshape(H, DK)
    log_f = jnp.logaddexp(jnp.log(lb), jnp.log1p(-lb) + jax.nn.log_sigmoid(f))
    k = (1.0 - lb) * jax.nn.sigmoid(-f)

    n = S // C

    def to_chunks(t):
        return t.reshape(B, n, C, H, t.shape[-1]).transpose(1, 0, 3, 2, 4)

    causal = jnp.tril(jnp.ones((C, C), dtype=bool))

    def step(state, chunk):
        qc, kc, gc, vc = chunk
        G = jnp.cumsum(gc, axis=2)
        inter = jnp.einsum('bhtd,bhde->bhte', qc * jnp.exp(G), state)
        diff = G[:, :, :, None, :] - G[:, :, None, :, :]
        decay = jnp.exp(jnp.where(causal[:, :, None], diff, -jnp.inf))
        A = jnp.einsum('bhtd,bhsd,bhtsd->bhts', qc, kc, decay)
        intra = jnp.einsum('bhts,bhse->bhte', A, vc)
        G_last = G[:, :, -1:, :]
        new_state = (jnp.exp(G_last[:, :, 0, :])[..., None] * state
                     + jnp.einsum('bhsd,bhse->bhde', kc * jnp.exp(G_last - G), vc))
        return new_state, inter + intra

    s0 = jnp.zeros((B, H, DK, DV), jnp.float32)
    _, o = lax.scan(step, s0, (to_chunks(q), to_chunks(k), to_chunks(log_f), to_chunks(v)))
    o = o.transpose(1, 0, 3, 2, 4).reshape(B, S, H, DV)
    o = rms_norm(o, out_norm.reshape(H, DV))
    o = o * jax.nn.silu(gate.astype(jnp.float32)).reshape(B, S, H, DV)
    return o.reshape(B, S, H * DV).astype(x.dtype) @ w_o


def swiglu_ffn(x, w_in, w_down):
    h = x @ w_in
    g, u = h[..., :D_FF], h[..., D_FF:]
    return (jax.nn.silu(g) * u) @ w_down


def setup_inputs(seed: int = 0) -> dict:
    key = jax.random.key(seed)
    ks = jax.random.split(key, 24)

    def w(k, shape, fan_in, scale=1.0):
        return jax.random.normal(k, shape, jnp.float32) * (fan_in ** -0.5) * scale

    def gain(k, shape):
        return 1.0 + 0.05 * jax.random.normal(k, shape, jnp.float32)

    def bias(k, shape):
        return 0.02 * jax.random.normal(k, shape, jnp.float32)

    NM, NH = N_MLA_LAYERS, N_HGRN_LAYERS
    return {
        'x': jax.random.normal(ks[0], (BATCH, SEQ, D_MODEL), jnp.float32),
        'p': jax.random.normal(ks[1], (DEPTH, BATCH, SEQ, D_PLE), jnp.float32),
        'positions': jnp.tile(jnp.arange(SEQ, dtype=jnp.int32)[None, :], (BATCH, 1)),
        'mla_w_dqkv': w(ks[2], (NM, D_MODEL, MLA_Q_LORA + MLA_KV_LORA + MLA_ROPE), D_MODEL),
        'mla_q_norm': gain(ks[3], (NM, MLA_Q_LORA)),
        'mla_kv_norm': gain(ks[4], (NM, MLA_KV_LORA)),
        'mla_w_uq': w(ks[5], (NM, MLA_Q_LORA, MLA_HEADS * (MLA_NOPE + MLA_ROPE)), MLA_Q_LORA),
        'mla_w_ukv': w(ks[6], (NM, MLA_KV_LORA, MLA_HEADS * (MLA_NOPE + MLA_V)), MLA_KV_LORA),
        'mla_w_o': w(ks[7], (NM, MLA_HEADS * MLA_V, D_MODEL), MLA_HEADS * MLA_V, DEEPNORM_BETA),
        'hgrn_w_in': w(ks[8], (NH, D_MODEL, 2 * HGRN_HEADS * HGRN_DK + 2 * HGRN_HEADS * HGRN_DV), D_MODEL),
        'hgrn_lb_logits': 0.1 * jax.random.normal(ks[9], (DEPTH, HGRN_HEADS * HGRN_DK), jnp.float32),
        'hgrn_out_norm': gain(ks[10], (NH, HGRN_HEADS * HGRN_DV)),
        'hgrn_w_o': w(ks[11], (NH, HGRN_HEADS * HGRN_DV, D_MODEL), HGRN_HEADS * HGRN_DV, DEEPNORM_BETA),
        'ffn_w_in': w(ks[12], (DEPTH, D_MODEL, 2 * D_FF), D_MODEL),
        'ffn_w_down': w(ks[13], (DEPTH, D_FF, D_MODEL), D_FF, DEEPNORM_BETA),
        'ln_mix_g': gain(ks[14], (DEPTH, D_MODEL)),
        'ln_mix_b': bias(ks[15], (DEPTH, D_MODEL)),
        'ln_ffn_g': gain(ks[16], (DEPTH, D_MODEL)),
        'ln_ffn_b': bias(ks[17], (DEPTH, D_MODEL)),
        'ple_w_proj': w(ks[18], (DEPTH, D_PLE, D_MODEL), D_PLE),
        'ple_w_gate': w(ks[19], (DEPTH, D_MODEL, D_MODEL), D_MODEL),
    }


def reference(x, p, positions, mla_w_dqkv, mla_q_norm, mla_kv_norm, mla_w_uq, mla_w_ukv, mla_w_o,
              hgrn_w_in, hgrn_lb_logits, hgrn_out_norm, hgrn_w_o, ffn_w_in, ffn_w_down,
              ln_mix_g, ln_mix_b, ln_ffn_g, ln_ffn_b, ple_w_proj, ple_w_gate):
    cos, sin = rope_tables(positions)
    lb_soft = jax.nn.softmax(hgrn_lb_logits.astype(jnp.float32), axis=0)
    lower_bounds = jnp.cumsum(lb_soft, axis=0) - lb_soft[0:1]

    for i in range(DEPTH):
        j = i // N_MIXERS
        if i % N_MIXERS == 0:
            h = mla_mixer(x, cos, sin, mla_w_dqkv[j], mla_q_norm[j], mla_kv_norm[j],
                          mla_w_uq[j], mla_w_ukv[j], mla_w_o[j])
        else:
            h = hgrn2_mixer(x, lower_bounds[i], hgrn_w_in[j], hgrn_out_norm[j], hgrn_w_o[j])
        x = layer_norm(DEEPNORM_ALPHA * x + h, ln_mix_g[i], ln_mix_b[i])
        x = layer_norm(DEEPNORM_ALPHA * x + swiglu_ffn(x, ffn_w_in[i], ffn_w_down[i]), ln_ffn_g[i], ln_ffn_b[i])
        x = x + jax.nn.sigmoid(x @ ple_w_gate[i]) * (p[i] @ ple_w_proj[i])
    return x
```

```cpp
#include <hip/hip_runtime.h>
#include <hip/hip_cooperative_groups.h>
#include <cstdio>
#include <cstdint>
namespace cg = cooperative_groups;

namespace pg8 {
#define PG8_LAS __attribute__((address_space(3)))
typedef unsigned short bf16_t;
typedef short bf16x8 __attribute__((ext_vector_type(8)));
typedef float f32x4 __attribute__((ext_vector_type(4)));
typedef unsigned u32x4 __attribute__((ext_vector_type(4)));
constexpr int BM = 256, BK = 64, HALF = 128, HTB = HALF * BK * 2  , STAGE_BYTES = 8 * HTB, NXCD = 8, WGM = 8;

__host__ __device__ __forceinline__ int lds_byte(int r, int c) { const int st = (r >> 4) * 2 + (c >> 5), rr = r & 15, cc = c & 31, ob = rr * 64 + cc * 2; return st * 1024 + (ob ^ (((ob >> 9) & 1) << 5)); }
__host__ __device__ __forceinline__ void stage_rc(int b, int& R, int& C) { const int st = b / 1024, sb = b % 1024, swz = sb ^ (((sb >> 9) & 1) << 5); R = (st >> 1) * 16 + swz / 64; C = (st & 1) * 32 + (swz % 64) / 2; }
__host__ __device__ __forceinline__ int perm32(int rho) { const int n = rho >> 4, i = rho & 15; return 8 * (i >> 2) + 4 * n + (i & 3); }

struct Unit { int pm, pn; };
struct Gemm { const bf16_t* A; const bf16_t* Bt; int M, N, K; };

struct StaticOrder {
    int nM, nN, nwg, G, c;
    __host__ __device__ void init(int M, int N, int G_, int c_) { nM = M / BM; nN = N / BM; nwg = nM * nN; G = G_; c = c_; }
    __host__ __device__ bool next(int i, Unit& u) const {
        const long L = (long)i * G + c; if (L >= nwg) return false;
        int wgid = (int)L; { const int q = nwg / NXCD, r = nwg % NXCD, xcd = wgid % NXCD, off = wgid / NXCD; wgid = (xcd < r ? xcd * (q + 1) : r * (q + 1) + (xcd - r) * q) + off; }
        const int nig = WGM * nN, gid = wgid / nig, fm = gid * WGM, gsz = (nM - fm) < WGM ? (nM - fm) : WGM;
        u.pm = fm + ((wgid % nig) % gsz); u.pn = (wgid % nig) / gsz; return true;
    }
    __device__ __forceinline__ void a_ready(const Unit&) const {}
    __device__ __forceinline__ void done(const Unit&) const {}
};

template <class Epi, class Sched, bool ALIGN_EPI = false, bool SP2 = false>
__device__ __forceinline__ void gemm_phase(PG8_LAS unsigned char* lds, const Gemm g, const Sched& S, const Epi& E) {
    int tid_ = threadIdx.x; asm volatile("" : "+v"(tid_));
    const int tid = tid_, wid = __builtin_amdgcn_readfirstlane(tid >> 6), lane = tid & 63, wr = wid >> 2, wc = wid & 3, fr = lane & 15, fq = lane >> 4;
    const int K = g.K, nt = K / BK;
    unsigned voffA[2], voffB[2];
#pragma unroll
    for (int i = 0; i < 2; ++i) { int R, C; stage_rc(tid * 16 + i * 8192, R, C); const int Rb = Epi::PERM ? ((R & ~31) + perm32(R & 31)) : R;
        voffA[i] = (unsigned)(R * K + C) * 2u; voffB[i] = (unsigned)(Rb * K + C) * 2u; }
    const size_t kstep = (size_t)(BK * 2);
    const size_t hstep = (size_t)HALF * K * 2;
    const size_t tstep = 2 * hstep;
    const unsigned ldsw = (unsigned)wid * 1024u;
    const int aoff = lds_byte(wr * 64 + fr, fq * 8), boff = lds_byte(wc * 32 + fr, fq * 8);
#define PG8_SA(b, h) (((b) * 2 + (h)) * HTB)
#define PG8_SB(b, h) ((4 + (b) * 2 + (h)) * HTB)
#define PG8_STAGE(bufoff, gbase, voff) do { _Pragma("unroll") for (int _i = 0; _i < 2; ++_i) \
        __builtin_amdgcn_global_load_lds((const unsigned*)((const char*)(gbase) + (voff)[_i]), (PG8_LAS unsigned*)(lds + (bufoff) + ldsw + _i * 8192), 16, 0, 0); } while (0)
#define PG8_LDA(dst, b, h) do { _Pragma("unroll") for (int m = 0; m < 4; ++m) _Pragma("unroll") for (int k = 0; k < 2; ++k) dst[m][k] = *(const PG8_LAS bf16x8*)(lds + PG8_SA(b, h) + aoff + m * 2048 + k * 1024); } while (0)
#define PG8_LDB(dst, b, h) do { _Pragma("unroll") for (int n = 0; n < 2; ++n) _Pragma("unroll") for (int k = 0; k < 2; ++k) dst[n][k] = *(const PG8_LAS bf16x8*)(lds + PG8_SB(b, h) + boff + n * 2048 + k * 1024); } while (0)
#define PG8_MMA(ai, bj, At, Bt) do { __builtin_amdgcn_s_setprio(1); _Pragma("unroll") for (int m = 0; m < 4; ++m) _Pragma("unroll") for (int n = 0; n < 2; ++n) _Pragma("unroll") for (int k = 0; k < 2; ++k) \
        acc[ai][bj][m][n] = __builtin_amdgcn_mfma_f32_16x16x32_bf16(Bt[n][k], At[m][k], acc[ai][bj][m][n], 0, 0, 0); __builtin_amdgcn_s_setprio(0); } while (0)
#define PG8_WAIT_V(n) asm volatile("s_waitcnt vmcnt(" #n ")" ::: "memory")
#define PG8_WAIT_L(n) asm volatile("s_waitcnt lgkmcnt(" #n ")" ::: "memory")
#define PG8_BAR __builtin_amdgcn_s_barrier()
#define PG8_SCHED __builtin_amdgcn_sched_barrier(0)
    Unit cur, nxt; int ui = 0;
    if (!S.next(0, cur)) return;
    f32x4 acc[2][2][4][2];
#pragma unroll
    for (int a = 0; a < 2; ++a)
#pragma unroll
        for (int b = 0; b < 2; ++b)
#pragma unroll
            for (int m = 0; m < 4; ++m)
#pragma unroll
                for (int n = 0; n < 2; ++n) acc[a][b][m][n] = (f32x4){0.f, 0.f, 0.f, 0.f};
    bf16x8 At[4][2], B0[2][2], B1[2][2];
    const char* cA = (const char*)g.A + (size_t)cur.pm * tstep; const char* cB = (const char*)g.Bt + (size_t)cur.pn * tstep;
    S.a_ready(cur);
    if constexpr (SP2) {
        PG8_STAGE(PG8_SB(0, 0), cB, voffB); PG8_STAGE(PG8_SB(0, 1), cB + hstep, voffB); PG8_STAGE(PG8_SA(0, 0), cA, voffA); PG8_STAGE(PG8_SA(0, 1), cA + hstep, voffA);
        if (wr == 1) PG8_BAR;
        PG8_WAIT_V(2); PG8_BAR;
        PG8_STAGE(PG8_SB(1, 0), cB + kstep, voffB); PG8_STAGE(PG8_SA(1, 0), cA + kstep, voffA); PG8_STAGE(PG8_SB(1, 1), cB + hstep + kstep, voffB);
        PG8_WAIT_V(6); PG8_BAR;
    } else {
        PG8_STAGE(PG8_SB(0, 0), cB, voffB); PG8_STAGE(PG8_SA(0, 0), cA, voffA); PG8_STAGE(PG8_SB(0, 1), cB + hstep, voffB); PG8_STAGE(PG8_SA(0, 1), cA + hstep, voffA);
        if (wr == 1) PG8_BAR;
        PG8_WAIT_V(4); PG8_BAR;
        PG8_STAGE(PG8_SB(1, 0), cB + kstep, voffB); PG8_STAGE(PG8_SA(1, 0), cA + kstep, voffA); PG8_STAGE(PG8_SB(1, 1), cB + hstep + kstep, voffB);
        PG8_WAIT_V(6); PG8_BAR;
    }
    for (;;) {
        const bool has_next = S.next(ui + 1, nxt);
        const char* nA = has_next ? (const char*)g.A + (size_t)nxt.pm * tstep : cA; const char* nB = has_next ? (const char*)g.Bt + (size_t)nxt.pn * tstep : cB;
        for (int t = 0; t < nt; t += 2) {
            const bool last = (t == nt - 2);
            const char* a1 = cA + (size_t)(t + 1) * kstep;
            const char* a2 = last ? nA : cA + (size_t)(t + 2) * kstep; const char* b2 = last ? nB : cB + (size_t)(t + 2) * kstep;
            const char* a3 = a2 + kstep; const char* b3 = b2 + kstep;
            if (last && has_next) S.a_ready(nxt);
            if constexpr (SP2) {
            PG8_LDB(B0, 0, 0); PG8_LDB(B1, 0, 1); PG8_SCHED; PG8_LDA(At, 0, 0); PG8_STAGE(PG8_SA(1, 1), a1 + hstep, voffA);
            PG8_WAIT_V(8); PG8_WAIT_L(0); PG8_BAR; PG8_MMA(0, 0, At, B0); PG8_MMA(0, 1, At, B1); PG8_BAR; PG8_SCHED;
            PG8_LDA(At, 0, 1); PG8_STAGE(PG8_SB(0, 0), b2, voffB); PG8_STAGE(PG8_SB(0, 1), b2 + hstep, voffB); PG8_STAGE(PG8_SA(0, 0), a2, voffA);
            PG8_WAIT_V(8); PG8_WAIT_L(0); PG8_BAR; PG8_MMA(1, 0, At, B0); PG8_MMA(1, 1, At, B1); PG8_BAR; PG8_SCHED;
            PG8_LDB(B0, 1, 0); PG8_LDB(B1, 1, 1); PG8_SCHED; PG8_LDA(At, 1, 0); PG8_STAGE(PG8_SA(0, 1), a2 + hstep, voffA);
            PG8_WAIT_V(8); PG8_WAIT_L(0); PG8_BAR; PG8_MMA(0, 0, At, B0); PG8_MMA(0, 1, At, B1); PG8_BAR; PG8_SCHED;
            PG8_LDA(At, 1, 1); PG8_STAGE(PG8_SB(1, 0), b3, voffB); PG8_STAGE(PG8_SB(1, 1), b3 + hstep, voffB); PG8_STAGE(PG8_SA(1, 0), a3, voffA);
            PG8_WAIT_V(8); PG8_WAIT_L(0); PG8_BAR; PG8_MMA(1, 0, At, B0); PG8_MMA(1, 1, At, B1); PG8_BAR; PG8_SCHED;
            } else {
            PG8_LDB(B0, 0, 0); PG8_SCHED; PG8_LDA(At, 0, 0); PG8_STAGE(PG8_SA(1, 1), a1 + hstep, voffA);
            PG8_WAIT_L(8); PG8_BAR; PG8_WAIT_L(0); PG8_MMA(0, 0, At, B0); PG8_BAR; PG8_SCHED;
            PG8_LDB(B1, 0, 1); PG8_STAGE(PG8_SB(0, 0), b2, voffB);
            PG8_BAR; PG8_WAIT_L(0); PG8_MMA(0, 1, At, B1); PG8_BAR;
            PG8_LDA(At, 0, 1); PG8_STAGE(PG8_SA(0, 0), a2, voffA);
            PG8_BAR; PG8_WAIT_L(0); PG8_MMA(1, 0, At, B0); PG8_BAR; PG8_SCHED;
            PG8_STAGE(PG8_SB(0, 1), b2 + hstep, voffB);
            PG8_WAIT_V(6); PG8_BAR; PG8_MMA(1, 1, At, B1); PG8_BAR;
            PG8_LDB(B0, 1, 0); PG8_SCHED; PG8_LDA(At, 1, 0); PG8_STAGE(PG8_SA(0, 1), a2 + hstep, voffA);
            PG8_WAIT_L(8); PG8_BAR; PG8_WAIT_L(0); PG8_MMA(0, 0, At, B0); PG8_BAR; PG8_SCHED;
            PG8_LDB(B1, 1, 1); PG8_STAGE(PG8_SB(1, 0), b3, voffB);
            PG8_BAR; PG8_WAIT_L(0); PG8_MMA(0, 1, At, B1); PG8_BAR;
            PG8_LDA(At, 1, 1); PG8_STAGE(PG8_SA(1, 0), a3, voffA);
            PG8_BAR; PG8_WAIT_L(0); PG8_MMA(1, 0, At, B0); PG8_BAR; PG8_SCHED;
            PG8_STAGE(PG8_SB(1, 1), b3 + hstep, voffB);
            PG8_WAIT_V(6); PG8_BAR; PG8_MMA(1, 1, At, B1); PG8_BAR;
            }
        }
        if constexpr (ALIGN_EPI) { if (wr == 0) PG8_BAR; }
        if constexpr (!Epi::AFTER_DRAIN) { E(acc, cur, wr, wc, fr, fq); S.done(cur); }
        if (!has_next) break;
#pragma unroll
        for (int a = 0; a < 2; ++a)
#pragma unroll
            for (int b = 0; b < 2; ++b)
#pragma unroll
                for (int m = 0; m < 4; ++m)
#pragma unroll
                    for (int n = 0; n < 2; ++n) acc[a][b][m][n] = (f32x4){0.f, 0.f, 0.f, 0.f};
        cur = nxt; cA = nA; cB = nB; ++ui;
        if constexpr (ALIGN_EPI) { if (wr == 1) PG8_BAR; }
    }
    PG8_WAIT_V(0);
    if constexpr (!ALIGN_EPI) { if (wr == 0) PG8_BAR; }
    PG8_BAR;
    if constexpr (Epi::AFTER_DRAIN) { E.fused(acc, cur, wr, wc, fr, fq, lds, wid, lane); S.done(cur); }
#undef PG8_SA
#undef PG8_SB
#undef PG8_STAGE
#undef PG8_LDA
#undef PG8_LDB
#undef PG8_MMA
#undef PG8_WAIT_V
#undef PG8_WAIT_L
#undef PG8_BAR
#undef PG8_SCHED
}
}
#define LAS __attribute__((address_space(3)))
typedef unsigned short bf16_t;
typedef short bf16x8 __attribute__((ext_vector_type(8)));
typedef short s16x4 __attribute__((ext_vector_type(4)));
typedef float f32x4 __attribute__((ext_vector_type(4)));
typedef float f32x16 __attribute__((ext_vector_type(16)));
typedef unsigned u32x4 __attribute__((ext_vector_type(4)));
typedef unsigned u32x2 __attribute__((ext_vector_type(2)));
typedef __bf16 bf16x2_t __attribute__((ext_vector_type(2)));
typedef float f32x2_t __attribute__((ext_vector_type(2)));
typedef LAS unsigned char* ldsp;

#define DI __device__ __forceinline__
DI unsigned pk2(float lo, float hi) { f32x2_t v = {lo, hi}; bf16x2_t b = __builtin_convertvector(v, bf16x2_t); return __builtin_bit_cast(unsigned, b); }
DI float bflo(unsigned u) { return __builtin_bit_cast(float, u << 16); }
DI float bfhi(unsigned u) { return __builtin_bit_cast(float, u & 0xffff0000u); }
DI float bf2f(bf16_t u) { return __builtin_bit_cast(float, (unsigned)u << 16); }
DI bf16_t f2bf(float f) { return (bf16_t)(pk2(f, 0.f) & 0xffffu); }
DI float sigmoidf_(float x) { return __builtin_amdgcn_rcpf(1.0f + __expf(-x)); }
DI float siluf_(float x) { return x * __builtin_amdgcn_rcpf(1.0f + __expf(-x)); }
DI int crow(int reg, int hh) { return (reg & 3) + 8 * (reg >> 2) + 4 * hh; }
#define MFMA32(a, b, c) __builtin_amdgcn_mfma_f32_32x32x16_bf16((a), (b), (c), 0, 0, 0)
DI bf16x8 pack8(const f32x16& x, int s) {
    u32x4 p; p.x = pk2(x[8 * s + 0], x[8 * s + 1]); p.y = pk2(x[8 * s + 2], x[8 * s + 3]); p.z = pk2(x[8 * s + 4], x[8 * s + 5]); p.w = pk2(x[8 * s + 6], x[8 * s + 7]);
    return __builtin_bit_cast(bf16x8, p);
}
DI bf16x8 lds_8x2(ldsp p, int gap) {
    s16x4 lo = *(const LAS s16x4*)p, hi = *(const LAS s16x4*)(p + gap);
    return __builtin_shufflevector(lo, hi, 0, 1, 2, 3, 4, 5, 6, 7);
}
DI void lds_w8x2(ldsp p, u32x4 v) { u32x2 a = {v.x, v.y}, b = {v.z, v.w}; *(LAS u32x2*)p = a; *(LAS u32x2*)(p + 8) = b; }
DI float wave_sum(float v) {
#pragma unroll
    for (int o = 1; o < 64; o <<= 1) v += __shfl_xor(v, o);
    return v;
}
DI float xrow16_sum(float x) {
    auto s = __builtin_amdgcn_permlane16_swap(__float_as_uint(x), __float_as_uint(x), false, false);
    x = __uint_as_float(s[0]) + __uint_as_float(s[1]);
    auto t = __builtin_amdgcn_permlane32_swap(__float_as_uint(x), __float_as_uint(x), false, false);
    return __uint_as_float(t[0]) + __uint_as_float(t[1]);
}
DI void sincos_rad(float ang, float& s, float& c) {
    double r = (double)ang * 0.15915494309189535; r -= __builtin_rint(r); const float f = (float)r;
    s = __builtin_amdgcn_sinf(f); c = __builtin_amdgcn_cosf(f);
}

constexpr int BATCH = 8, SEQ = 8192, DM = 1024, MTOK = BATCH * SEQ;
constexpr int DFF = 2816, DPLE = 256;
constexpr float LN_EPS = 1e-5f, RMS_EPS = 1e-6f;
constexpr float ALPHA = 1.4142135623730951f;
constexpr float QSCALE = 0.07216878364870322f * 1.4426950408889634f;
constexpr size_t MiB = 1u << 20;
constexpr size_t WS_W = 1 * MiB, WS_DEC = 60 * MiB, WS_PB = 64 * MiB, WS_XB = 128 * MiB, WS_XF = 256 * MiB, WS_XB2 = 512 * MiB, WS_Y = 640 * MiB, WS_PP = 896 * MiB;
constexpr size_t WS_Q = 256 * MiB, WS_DQ = 448 * MiB, WS_DKV = 480 * MiB, WS_KN = 512 * MiB, WS_VT = 896 * MiB, WS_H = 512 * MiB;
constexpr size_t WS_HQ = 128 * MiB, WS_LOGF = 640 * MiB, WS_HK = 896 * MiB, WS_KHT = 256 * MiB, WS_HO = 640 * MiB, WS_HA = 768 * MiB;
constexpr size_t DO_O = 0, DO_KR = 128 * MiB, DO_SSQ = 136 * MiB, DO_HVT = 0, DO_HG = 128 * MiB, DO_HA = 0;
constexpr size_t WS_ST1 = 864 * MiB, WS_ST2 = 872 * MiB, WS_PART = 55 * MiB;
constexpr size_t C_CSF = 0, C_BWF = 2 * 5632, C_CSG = 4 * 5632, C_BWG = 4 * 5632 + 2 * 1024;
constexpr size_t P_FIN = 0, P_PG = 4 * 16 * 5632;
constexpr size_t W_DQKV = 0, W_UQ = W_DQKV + 768 * 1024, W_UK = W_UQ + 1536 * 256, W_UV = W_UK + 1024 * 256, W_WO = W_UV + 1024 * 256,
                 W_HIN = W_WO + 1024 * 1024, W_HO = W_HIN + 4096 * 1024, W_FIN = W_HO + 1024 * 1024, W_FDN = W_FIN + 2 * 5632 * 1024,
                 W_PPJ = W_FDN + 2 * 1024 * 2816, W_PG = W_PPJ + 2 * 1024 * 256, W_END = W_PG + 2 * 1024 * 1024;
static_assert(WS_W + W_END * 2 <= WS_DEC, "weights fit");
constexpr int LDS_BYTES = 147456 + 1024;
#define EPI_COMMON static constexpr bool PERM = true, AFTER_DRAIN = false;
#define EPI_SIG (const f32x4 (&acc)[2][2][4][2], const pg8::Unit& u, int wr, int wc, int fr, int fq) const
#define UNROLL _Pragma("unroll")
DI u32x4 pk8(const f32x4& a, const f32x4& b) { u32x4 w; w.x = pk2(a[0], a[1]); w.y = pk2(a[2], a[3]); w.z = pk2(b[0], b[1]); w.w = pk2(b[2], b[3]); return w; }
constexpr float ROPE_L2 = 0.4152410118609203f;

DI void rope_sc(float p, int i0, f32x4& s, f32x4& c) {
    UNROLL for (int j = 0; j < 4; ++j) { const float invf = exp2f(-(float)(i0 + j) * ROPE_L2); float sj, cj; sincos_rad(p * invf, sj, cj); s[j] = sj; c[j] = cj; }
}
DI u32x4 rope_apply(const f32x4& t1, const f32x4& t2, const f32x4& s, const f32x4& c) {
    const f32x4 o1 = t1 * c - t2 * s, o2 = t2 * c + t1 * s; return pk8(o1, o2);
}
struct EpiDown { EPI_COMMON bf16_t* DQ; bf16_t* DKV; bf16_t* KR; float* SSQ; const int* pos;
    DI void operator() EPI_SIG {
        const size_t row0 = (size_t)u.pm * 256 + wr * 64 + fr;
        if (u.pn < 2) {
            bf16_t* dst = u.pn == 0 ? DQ : DKV;
            UNROLL for (int ai = 0; ai < 2; ++ai) UNROLL for (int m = 0; m < 4; ++m) { const size_t row = row0 + ai * 128 + m * 16; float ss = 0.f;
                UNROLL for (int bj = 0; bj < 2; ++bj) { const f32x4 v0 = acc[ai][bj][m][0], v1 = acc[ai][bj][m][1];
                    ss += v0[0] * v0[0] + v0[1] * v0[1] + v0[2] * v0[2] + v0[3] * v0[3] + v1[0] * v1[0] + v1[1] * v1[1] + v1[2] * v1[2] + v1[3] * v1[3];
                    *(u32x4*)(dst + row * 256 + bj * 128 + wc * 32 + 8 * fq) = pk8(v0, v1); }
                ss = xrow16_sum(ss);
                if (fq == 0) SSQ[row * 8 + u.pn * 4 + wc] = ss; }
        } else if (wc < 2) {
            const int g = 4 * wc + fq;
            UNROLL for (int ai = 0; ai < 2; ++ai) UNROLL for (int m = 0; m < 4; ++m) { const size_t row = row0 + ai * 128 + m * 16;
                f32x4 sn, cs; rope_sc((float)pos[row], 4 * g, sn, cs); *(u32x4*)(KR + row * 64 + 8 * g) = rope_apply(acc[ai][0][m][0], acc[ai][0][m][1], sn, cs); }
        }
    }
};
struct EpiUQ { EPI_COMMON bf16_t* Q; const float* SSQ; const int* pos;
    DI void operator() EPI_SIG {
        const size_t row0 = (size_t)u.pm * 256 + wr * 64 + fr;
        float rsa[2][4];
        UNROLL for (int ai = 0; ai < 2; ++ai) UNROLL for (int m = 0; m < 4; ++m) { const f32x4 sq = *(const f32x4*)(SSQ + (row0 + ai * 128 + m * 16) * 8); rsa[ai][m] = rsqrtf((sq[0] + sq[1] + sq[2] + sq[3]) * (1.0f / 256.0f) + RMS_EPS); }
        UNROLL for (int ai = 0; ai < 2; ++ai) UNROLL for (int m = 0; m < 4; ++m) { const size_t row = row0 + ai * 128 + m * 16;
            const float rstd = rsa[ai][m];
            if (u.pn < 4) {
                UNROLL for (int bj = 0; bj < 2; ++bj) { const int h = 2 * u.pn + bj;
                    *(u32x4*)(Q + row * 1536 + h * 192 + wc * 32 + 8 * fq) = pk8(acc[ai][bj][m][0] * rstd, acc[ai][bj][m][1] * rstd); }
            } else {
                const int g = 4 * (wc & 1) + fq; f32x4 sn, cs; rope_sc((float)pos[row], 4 * g, sn, cs); sn = sn * rstd; cs = cs * rstd;
                UNROLL for (int bj = 0; bj < 2; ++bj) { const int cc = 256 * (u.pn - 4) + 128 * bj + 32 * wc, h = cc >> 6;
                    *(u32x4*)(Q + row * 1536 + h * 192 + 128 + 8 * g) = rope_apply(acc[ai][bj][m][0], acc[ai][bj][m][1], sn, cs); }
            }
        }
    }
};
struct EpiUK { EPI_COMMON bf16_t* O; const float* SSQ;
    DI void operator() EPI_SIG {
        const size_t row0 = (size_t)u.pm * 256 + wr * 64 + fr; const int col0 = u.pn * 256 + wc * 32 + 8 * fq;
        float rsa[2][4];
        UNROLL for (int ai = 0; ai < 2; ++ai) UNROLL for (int m = 0; m < 4; ++m) { const f32x4 sq = *(const f32x4*)(SSQ + (row0 + ai * 128 + m * 16) * 8 + 4); rsa[ai][m] = rsqrtf((sq[0] + sq[1] + sq[2] + sq[3]) * (1.0f / 256.0f) + RMS_EPS); }
        UNROLL for (int ai = 0; ai < 2; ++ai) UNROLL for (int m = 0; m < 4; ++m) { const size_t row = row0 + ai * 128 + m * 16;
            const float rstd = rsa[ai][m];
            UNROLL for (int bj = 0; bj < 2; ++bj) *(u32x4*)(O + row * 1024 + col0 + bj * 128) = pk8(acc[ai][bj][m][0] * rstd, acc[ai][bj][m][1] * rstd); }
    }
};
struct EpiVT { EPI_COMMON bf16_t* O; const float* SSQ;
    DI void operator() EPI_SIG {
        const size_t row0 = (size_t)u.pm * 256 + wr * 64 + fr; const int col0 = u.pn * 256 + wc * 32 + 8 * fq;
        UNROLL for (int bj = 0; bj < 2; ++bj) { f32x4 rs[2];
            UNROLL for (int n = 0; n < 2; ++n) UNROLL for (int j = 0; j < 4; ++j) { const size_t tok = (size_t)col0 + bj * 128 + 4 * n + j;
                const f32x4 sq = *(const f32x4*)(SSQ + tok * 8 + 4); rs[n][j] = rsqrtf((sq[0] + sq[1] + sq[2] + sq[3]) * (1.0f / 256.0f) + RMS_EPS); }
            UNROLL for (int ai = 0; ai < 2; ++ai) UNROLL for (int m = 0; m < 4; ++m) { const size_t row = row0 + ai * 128 + m * 16;
                const size_t col = (size_t)col0 + bj * 128; *(u32x4*)(O + ((col >> 6) * 1024 + row) * 64 + (col & 63)) = pk8(acc[ai][bj][m][0] * rs[0], acc[ai][bj][m][1] * rs[1]); } }
    }
};
struct EpiRes { EPI_COMMON const float* res; float* Y;
    DI void operator() EPI_SIG {
        const size_t row0 = (size_t)u.pm * 256 + wr * 64 + fr; const int col0 = u.pn * 256 + wc * 32 + 8 * fq;
        UNROLL for (int ai = 0; ai < 2; ++ai) UNROLL for (int m = 0; m < 4; ++m) { const size_t row = row0 + ai * 128 + m * 16;
            UNROLL for (int bj = 0; bj < 2; ++bj) UNROLL for (int n = 0; n < 2; ++n) { const size_t idx = row * 1024 + col0 + bj * 128 + 4 * n;
                const f32x4 r = *(const f32x4*)(res + idx); *(f32x4*)(Y + idx) = r * ALPHA + acc[ai][bj][m][n]; } }
    }
};
struct EpiSwiglu { EPI_COMMON bf16_t* H;
    DI void operator() EPI_SIG {
        const size_t row0 = (size_t)u.pm * 256 + wr * 64 + fr; const int col0 = u.pn * 128 + wc * 32 + 8 * fq;
        UNROLL for (int ai = 0; ai < 2; ++ai) UNROLL for (int m = 0; m < 4; ++m) { const size_t row = row0 + ai * 128 + m * 16;
            f32x4 h0, h1;
            UNROLL for (int j = 0; j < 4; ++j) { h0[j] = siluf_(acc[ai][0][m][0][j]) * acc[ai][1][m][0][j]; h1[j] = siluf_(acc[ai][0][m][1][j]) * acc[ai][1][m][1][j]; }
            *(u32x4*)(H + row * DFF + col0) = pk8(h0, h1); }
    }
};
template <bool CHUNKED> struct EpiBf16 { EPI_COMMON bf16_t* O; size_t ldc;
    DI void operator() EPI_SIG {
        const size_t row0 = (size_t)u.pm * 256 + wr * 64 + fr; const int col0 = u.pn * 256 + wc * 32 + 8 * fq;
        UNROLL for (int ai = 0; ai < 2; ++ai) UNROLL for (int m = 0; m < 4; ++m) { const size_t row = row0 + ai * 128 + m * 16;
            UNROLL for (int bj = 0; bj < 2; ++bj) { const size_t col = (size_t)col0 + bj * 128;
                bf16_t* dst = CHUNKED ? O + ((col >> 6) * 1024 + row) * 64 + (col & 63) : O + row * ldc + col;
                *(u32x4*)dst = pk8(acc[ai][bj][m][0], acc[ai][bj][m][1]); } }
    }
};
struct EpiGate { EPI_COMMON const float* XF; const bf16_t* PP; float* OF; bf16_t* OB;
    DI void operator() EPI_SIG {
        const size_t row0 = (size_t)u.pm * 256 + wr * 64 + fr; const int col0 = u.pn * 256 + wc * 32 + 8 * fq;
        UNROLL for (int ai = 0; ai < 2; ++ai) UNROLL for (int m = 0; m < 4; ++m) { const size_t row = row0 + ai * 128 + m * 16;
            UNROLL for (int bj = 0; bj < 2; ++bj) { const size_t idx = row * 1024 + col0 + bj * 128;
                const u32x4 pp = *(const u32x4*)(PP + idx); const f32x4 x0 = *(const f32x4*)(XF + idx), x1 = *(const f32x4*)(XF + idx + 4);
                const f32x4 a0 = acc[ai][bj][m][0], a1 = acc[ai][bj][m][1]; f32x4 o0, o1;
                o0[0] = x0[0] + sigmoidf_(a0[0]) * bflo(pp.x); o0[1] = x0[1] + sigmoidf_(a0[1]) * bfhi(pp.x); o0[2] = x0[2] + sigmoidf_(a0[2]) * bflo(pp.y); o0[3] = x0[3] + sigmoidf_(a0[3]) * bfhi(pp.y);
                o1[0] = x1[0] + sigmoidf_(a1[0]) * bflo(pp.z); o1[1] = x1[1] + sigmoidf_(a1[1]) * bfhi(pp.z); o1[2] = x1[2] + sigmoidf_(a1[2]) * bflo(pp.w); o1[3] = x1[3] + sigmoidf_(a1[3]) * bfhi(pp.w);
                *(f32x4*)(OF + idx) = o0; *(f32x4*)(OF + idx + 4) = o1;
                if (OB) *(u32x4*)(OB + idx) = pk8(o0, o1); } }
    }
};
typedef float f32x2v __attribute__((ext_vector_type(2)));
DI void row_stats(const f32x2v* st, size_t row, int fq, float& mu, float& rstd) {
    const f32x4 a = *(const f32x4*)(st + row * 16 + 4 * fq), b = *(const f32x4*)(st + row * 16 + 4 * fq + 2);
    float s1 = (a[0] + a[2]) + (b[0] + b[2]), s2 = (a[1] + a[3]) + (b[1] + b[3]);
    s1 = xrow16_sum(s1); s2 = xrow16_sum(s2);
    mu = s1 * (1.0f / 1024.0f); const float var = fmaxf(s2 * (1.0f / 1024.0f) - mu * mu, 0.f); rstd = rsqrtf(var + LN_EPS);
}
DI void unpack8(const u32x4& p, f32x4& a, f32x4& b) { a[0] = bflo(p.x); a[1] = bfhi(p.x); a[2] = bflo(p.y); a[3] = bfhi(p.y); b[0] = bflo(p.z); b[1] = bfhi(p.z); b[2] = bflo(p.w); b[3] = bfhi(p.w); }
template <bool LNRES, bool RESBF> struct EpiRes2 { EPI_COMMON const void* res; const f32x2v* stp; const float* g; const float* b; bf16_t* YB; f32x2v* sto;
    DI void operator() EPI_SIG {
        const size_t row0 = (size_t)u.pm * 256 + wr * 64 + fr; const int col0 = u.pn * 256 + wc * 32 + 8 * fq;
        constexpr int MB = RESBF ? 4 : 2;
        UNROLL for (int ai = 0; ai < 2; ++ai) UNROLL for (int mp = 0; mp < 4 / MB; ++mp) {
            float mu[MB], rstd[MB]; u32x4 rb[MB][2]; f32x4 rf[RESBF ? 1 : MB][2][2];
            UNROLL for (int mm = 0; mm < MB; ++mm) { const size_t row = row0 + ai * 128 + (MB * mp + mm) * 16; mu[mm] = 0.f; rstd[mm] = 1.f; if (LNRES) row_stats(stp, row, fq, mu[mm], rstd[mm]);
                UNROLL for (int bj = 0; bj < 2; ++bj) { const size_t idx = row * 1024 + col0 + bj * 128;
                    if (RESBF) rb[mm][bj] = *(const u32x4*)((const bf16_t*)res + idx);
                    else { rf[RESBF ? 0 : mm][bj][0] = *(const f32x4*)((const float*)res + idx); rf[RESBF ? 0 : mm][bj][1] = *(const f32x4*)((const float*)res + idx + 4); } } }
            UNROLL for (int mm = 0; mm < MB; ++mm) { const int m = MB * mp + mm; const size_t row = row0 + ai * 128 + m * 16;
                float s1 = 0.f, s2 = 0.f;
                UNROLL for (int bj = 0; bj < 2; ++bj) { f32x4 yv[2], rr[2];
                    if (RESBF) unpack8(rb[mm][bj], rr[0], rr[1]); else { rr[0] = rf[RESBF ? 0 : mm][bj][0]; rr[1] = rf[RESBF ? 0 : mm][bj][1]; }
                    UNROLL for (int n = 0; n < 2; ++n) { const int col = col0 + bj * 128 + 4 * n;
                        f32x4 r1 = rr[n];
                        if (LNRES) r1 = (r1 - mu[mm]) * rstd[mm] * *(const f32x4*)(g + col) + *(const f32x4*)(b + col);
                        const f32x4 y = r1 * ALPHA + acc[ai][bj][m][n]; yv[n] = y;
                        s1 += (y[0] + y[1]) + (y[2] + y[3]); s2 += (y[0] * y[0] + y[1] * y[1]) + (y[2] * y[2] + y[3] * y[3]); }
                    *(u32x4*)(YB + row * 1024 + col0 + bj * 128) = pk8(yv[0], yv[1]); }
                s1 = xrow16_sum(s1); s2 = xrow16_sum(s2);
                if (fq == 0) { f32x2v o; o[0] = s1; o[1] = s2; sto[row * 16 + u.pn * 4 + wc] = o; } } }
    }
};
struct EpiSwigluLN { EPI_COMMON bf16_t* H; const f32x2v* st; const float* cs; const float* bw;
    DI void operator() EPI_SIG {
        const size_t row0 = (size_t)u.pm * 256 + wr * 64 + fr; const int col0 = u.pn * 128 + wc * 32 + 8 * fq, pc0 = u.pn * 256 + wc * 32 + 8 * fq;
        f32x4 csv[2][2], bwv[2][2];
        UNROLL for (int bj = 0; bj < 2; ++bj) UNROLL for (int n = 0; n < 2; ++n) { csv[bj][n] = *(const f32x4*)(cs + pc0 + bj * 128 + 4 * n); bwv[bj][n] = *(const f32x4*)(bw + pc0 + bj * 128 + 4 * n); }
        float mua[2][4], rsa[2][4];
        UNROLL for (int ai = 0; ai < 2; ++ai) UNROLL for (int m = 0; m < 4; ++m) row_stats(st, row0 + ai * 128 + m * 16, fq, mua[ai][m], rsa[ai][m]);
        UNROLL for (int ai = 0; ai < 2; ++ai) UNROLL for (int m = 0; m < 4; ++m) { const size_t row = row0 + ai * 128 + m * 16;
            const float mu = mua[ai][m], rstd = rsa[ai][m];
            f32x4 h[2];
            UNROLL for (int n = 0; n < 2; ++n) { const f32x4 gp = (acc[ai][0][m][n] - csv[0][n] * mu) * rstd + bwv[0][n], up = (acc[ai][1][m][n] - csv[1][n] * mu) * rstd + bwv[1][n];
                UNROLL for (int j = 0; j < 4; ++j) h[n][j] = siluf_(gp[j]) * up[j]; }
            *(u32x4*)(H + row * DFF + col0) = pk8(h[0], h[1]); }
    }
};
struct EpiGateLN { EPI_COMMON const bf16_t* Y2; const f32x2v* st; const float* g; const float* b; const float* cs; const float* bw; const bf16_t* PP; float* OF; bf16_t* OB;
    DI void operator() EPI_SIG {
        const size_t row0 = (size_t)u.pm * 256 + wr * 64 + fr; const int col0 = u.pn * 256 + wc * 32 + 8 * fq;
        UNROLL for (int ai = 0; ai < 2; ++ai) UNROLL for (int mp = 0; mp < 2; ++mp) {
            float mu[2], rstd[2]; u32x4 yv[2][2], ppv[2][2];
            UNROLL for (int mm = 0; mm < 2; ++mm) { const size_t row = row0 + ai * 128 + (2 * mp + mm) * 16; row_stats(st, row, fq, mu[mm], rstd[mm]);
                UNROLL for (int bj = 0; bj < 2; ++bj) { const size_t idx = row * 1024 + col0 + bj * 128; ppv[mm][bj] = *(const u32x4*)(PP + idx); yv[mm][bj] = *(const u32x4*)(Y2 + idx); } }
            UNROLL for (int mm = 0; mm < 2; ++mm) { const int m = 2 * mp + mm; const size_t row = row0 + ai * 128 + m * 16;
                UNROLL for (int bj = 0; bj < 2; ++bj) { const int col = col0 + bj * 128; const size_t idx = row * 1024 + col;
                    f32x4 ppf[2], yf[2]; unpack8(ppv[mm][bj], ppf[0], ppf[1]); unpack8(yv[mm][bj], yf[0], yf[1]);
                    f32x4 o[2];
                    UNROLL for (int n = 0; n < 2; ++n) { const int c = col + 4 * n;
                        const f32x4 xf = (yf[n] - mu[mm]) * rstd[mm] * *(const f32x4*)(g + c) + *(const f32x4*)(b + c);
                        const f32x4 gp = (acc[ai][bj][m][n] - *(const f32x4*)(cs + c) * mu[mm]) * rstd[mm] + *(const f32x4*)(bw + c);
                        UNROLL for (int j = 0; j < 4; ++j) o[n][j] = xf[j] + sigmoidf_(gp[j]) * ppf[n][j];
                        if (OF) *(f32x4*)(OF + idx + 4 * n) = o[n]; }
                    if (OB) *(u32x4*)(OB + idx) = pk8(o[0], o[1]); } } }
    }
};
struct EpiHin { EPI_COMMON bf16_t* QT; bf16_t* KT; bf16_t* KHT; float* DEC; bf16_t* HG; const float* logits;
    DI void operator() EPI_SIG {
        const size_t row0 = (size_t)u.pm * 256 + wr * 64 + fr;
        if (u.pn >= 8) {
            const int col0 = (u.pn - 8) * 256 + wc * 32 + 8 * fq;
            UNROLL for (int ai = 0; ai < 2; ++ai) UNROLL for (int m = 0; m < 4; ++m) { const size_t row = row0 + ai * 128 + m * 16;
                UNROLL for (int bj = 0; bj < 2; ++bj) { f32x4 s0, s1;
                    UNROLL for (int j = 0; j < 4; ++j) { s0[j] = siluf_(acc[ai][bj][m][0][j]); s1[j] = siluf_(acc[ai][bj][m][1][j]); }
                    *(u32x4*)(HG + row * 1024 + col0 + bj * 128) = pk8(s0, s1); } }
            return;
        }
        const int h = u.pn, d0 = wc * 32 + 8 * fq, lane = fq * 16 + fr;
        f32x4 lb[2];
        UNROLL for (int n = 0; n < 2; ++n) UNROLL for (int j = 0; j < 4; ++j) { const int c = h * 128 + d0 + 4 * n + j; lb[n][j] = __builtin_amdgcn_rcpf(1.0f + __expf(logits[c] - logits[1024 + c])); }
        UNROLL for (int ai = 0; ai < 2; ++ai) UNROLL for (int n = 0; n < 2; ++n) { unsigned wq0[4], wk0[4]; UNROLL for (int jp = 0; jp < 2; ++jp) {
            float Gc[4][2], kk[4][2];
            UNROLL for (int m = 0; m < 4; ++m) UNROLL for (int jj = 0; jj < 2; ++jj) {
                const float l = lb[n][2 * jp + jj], fv = l + (1.0f - l) * sigmoidf_(acc[ai][1][m][n][2 * jp + jj]); Gc[m][jj] = __logf(fv); kk[m][jj] = 1.0f - fv; }
            UNROLL for (int k = 1; k < 16; k <<= 1)
                UNROLL for (int m = 0; m < 4; ++m) UNROLL for (int jj = 0; jj < 2; ++jj) { const float t = __shfl_up(Gc[m][jj], k, 16); if (fr >= k) Gc[m][jj] += t; }
            float off[2] = {0.f, 0.f};
            UNROLL for (int m = 0; m < 4; ++m) UNROLL for (int jj = 0; jj < 2; ++jj) { const float tm = __shfl(Gc[m][jj], (lane & 48) | 15); Gc[m][jj] += off[jj]; off[jj] += tm; }
            const size_t cgi = (size_t)u.pm * 4 + ai * 2 + wr; const int dn = d0 + 4 * n + 2 * jp;
            bf16_t* khp = KHT + ((cgi * 8 + h) * 128 + dn) * 64 + fr;
            const float eoff[2] = {__expf(off[0]), __expf(off[1])};
            UNROLL for (int m = 0; m < 4; ++m) { const size_t row = row0 + ai * 128 + m * 16; float qt[2], kt[2];
                UNROLL for (int jj = 0; jj < 2; ++jj) { const float eng = __expf(-Gc[m][jj]), k = kk[m][jj];
                    qt[jj] = siluf_(acc[ai][0][m][n][2 * jp + jj]) * __builtin_amdgcn_rcpf(eng); kt[jj] = k * eng;
                    khp[(size_t)jj * 64 + 16 * m] = f2bf(kt[jj] * eoff[jj]); }
                if (jp == 0) { wq0[m] = pk2(qt[0], qt[1]); wk0[m] = pk2(kt[0], kt[1]); }
                else { u32x2 wq, wk; wq.x = wq0[m]; wq.y = pk2(qt[0], qt[1]); wk.x = wk0[m]; wk.y = pk2(kt[0], kt[1]);
                    *(u32x2*)(QT + row * 1024 + h * 128 + dn - 2) = wq; *(u32x2*)(KT + row * 1024 + h * 128 + dn - 2) = wk; } }
            if (fr == 0) { f32x2v e0; e0[0] = eoff[0]; e0[1] = eoff[1]; *(f32x2v*)(DEC + cgi * 1024 + h * 128 + dn) = e0; }
        } }
    }
};
enum { MAT_ID = 0, MAT_DQKV, MAT_UQ, MAT_UK, MAT_UV, MAT_HIN, MAT_FIN };
template <int MAT> DI int mapcol(int n) {
    if (MAT == MAT_DQKV) { if (n < 512) return n; if (n >= 576) return -1; const int w = n - 512, g = w >> 3, i8 = w & 7; return 512 + (i8 < 4 ? 4 * g + i8 : 32 + 4 * g + (i8 - 4)); }
    if (MAT == MAT_UQ) { if (n < 1024) return (n >> 7) * 192 + (n & 127); const int w = n - 1024, h = w >> 6, r = w & 63, g = r >> 3, i8 = r & 7; return h * 192 + 128 + (i8 < 4 ? 4 * g + i8 : 32 + 4 * g + (i8 - 4)); }
    if (MAT == MAT_UK) return (n >> 7) * 256 + (n & 127);
    if (MAT == MAT_UV) return (n >> 7) * 256 + 128 + (n & 127);
    if (MAT == MAT_HIN) { if (n < 2048) { const int t = n >> 8, r = n & 255; return r < 128 ? t * 128 + r : 1024 + t * 128 + (r - 128); } if (n < 3072) return n + 1024; return n - 1024; }
    if (MAT == MAT_FIN) { const int t = n >> 8, r = n & 255; return r < 128 ? 128 * t + r : DFF + 128 * t + (r - 128); }
    return n;
}
template <int MAT, bool STATS = false> DI void transpose_mat(const float* W, int K, int Nsrc, int Ndst, bf16_t* WT, const float* kscale, float sc, LAS float* scr, int gw, int NGW, int lane,
                                                             const float* kbias = nullptr, float* PC = nullptr, float* PB = nullptr) {
    const int nblk = Ndst / 32, items = (K / 64) * nblk;
    for (int it = gw; it < items; it += NGW) {
        const int kb = it / nblk, nb = it % nblk, k0 = 64 * kb, n0 = 32 * nb;
        const int src = mapcol<MAT>(n0 + (lane & 31));
        float pc = 0.f, pb = 0.f;
        float wv[32];
#pragma unroll
        for (int i = 0; i < 32; ++i) { const int kk = 2 * i + (lane >> 5); wv[i] = (src >= 0) ? __builtin_nontemporal_load(W + (size_t)(k0 + kk) * Nsrc + src) : 0.f; }
#pragma unroll
        for (int i = 0; i < 32; ++i) { const int kk = 2 * i + (lane >> 5); float v = wv[i] * sc;
            if (src >= 0) { if (STATS) pb += v * kbias[k0 + kk]; if (kscale) v *= kscale[k0 + kk]; if (STATS) pc += v; }
            scr[kk * 33 + (lane & 31)] = v; }
        if (STATS) { pc += __shfl_xor(pc, 32); pb += __shfl_xor(pb, 32); if (lane < 32) { PC[(size_t)kb * Ndst + n0 + lane] = pc; PB[(size_t)kb * Ndst + n0 + lane] = pb; } }
        asm volatile("s_waitcnt lgkmcnt(0)" ::: "memory");
        const int c = lane & 7;
#pragma unroll
        for (int j = 0; j < 4; ++j) { const int n = (lane >> 3) + 8 * j; const LAS float* s = scr + (8 * c) * 33 + n;
            u32x4 o; o.x = pk2(s[0 * 33], s[1 * 33]); o.y = pk2(s[2 * 33], s[3 * 33]); o.z = pk2(s[4 * 33], s[5 * 33]); o.w = pk2(s[6 * 33], s[7 * 33]);
            *(u32x4*)(WT + (size_t)(n0 + n) * K + k0 + 8 * c) = o; }
        asm volatile("s_waitcnt lgkmcnt(0)" ::: "memory");
    }
}
DI void cast_bf16(const float* src, bf16_t* dst, size_t n, size_t gt, size_t NGT) {
    for (size_t i = gt; i < n / 8; i += NGT) { const f32x4 a = *(const f32x4*)(src + 8 * i), b = *(const f32x4*)(src + 8 * i + 4); *(u32x4*)(dst + 8 * i) = pk8(a, b); }
}
DI void ln_pass(const float* Y, const float* g, const float* b, float* XF, bf16_t* XB, int gw, int NGW, int lane) {
    f32x4 gv[4], bv[4];
#pragma unroll
    for (int j = 0; j < 4; ++j) { gv[j] = *(const f32x4*)(g + 4 * lane + 256 * j); bv[j] = *(const f32x4*)(b + 4 * lane + 256 * j); }
    for (int row = gw; row < MTOK; row += NGW) {
        const float* y = Y + (size_t)row * 1024 + 4 * lane; f32x4 v[4]; float s = 0.f;
#pragma unroll
        for (int j = 0; j < 4; ++j) { v[j] = *(const f32x4*)(y + 256 * j); s += (v[j][0] + v[j][1]) + (v[j][2] + v[j][3]); }
        const float mean = wave_sum(s) * (1.0f / 1024.0f); float s2 = 0.f;
#pragma unroll
        for (int j = 0; j < 4; ++j) { v[j] = v[j] - mean; s2 += (v[j][0] * v[j][0] + v[j][1] * v[j][1]) + (v[j][2] * v[j][2] + v[j][3] * v[j][3]); }
        const float rstd = rsqrtf(wave_sum(s2) * (1.0f / 1024.0f) + LN_EPS);
#pragma unroll
        for (int j = 0; j < 4; ++j) { const f32x4 o = v[j] * rstd * gv[j] + bv[j]; const size_t idx = (size_t)row * 1024 + 4 * lane + 256 * j;
            *(f32x4*)(XF + idx) = o; u32x2 w; w.x = pk2(o[0], o[1]); w.y = pk2(o[2], o[3]); *(u32x2*)(XB + idx) = w; }
    }
}
constexpr int AT_KP = 400, AT_VP = 136, AT_VOFF = 64 * AT_KP, AT_BUF = AT_VOFF + 128 * AT_VP;
static_assert(2 * AT_BUF <= 131072, "attention LDS");
DI void attn_phase(ldsp lds, const bf16_t* Q, const bf16_t* KN, const bf16_t* KR, const bf16_t* VT, bf16_t* O, int vcu, int G) {
    int tid_ = threadIdx.x; asm volatile("" : "+v"(tid_));
    const int tid = tid_, wid = __builtin_amdgcn_readfirstlane(tid >> 6), lane = tid & 63, l31 = lane & 31, hh = lane >> 5;
    for (int pr = vcu; pr < 1024; pr += G) {
        const int bh = pr >> 4, jj = pr & 15, b = bh >> 3, h = bh & 7;
        const size_t tok0 = (size_t)b * SEQ;
#pragma unroll 1
        for (int half = 0; half < 2; ++half) {
            const int qb = half == 0 ? 31 - jj : jj;
            const int q0 = qb * 256 + wid * 32;
            bf16x8 qf[12];
            { const bf16_t* qp = Q + (tok0 + q0 + l31) * 1536 + h * 192 + hh * 8;
#pragma unroll
              for (int ks = 0; ks < 12; ++ks) qf[ks] = *(const bf16x8*)(qp + ks * 16); }
            f32x16 o[4];
#pragma unroll
            for (int d = 0; d < 4; ++d)
#pragma unroll
                for (int r = 0; r < 16; ++r) o[d][r] = 0.f;
            float mrun = -1e30f, lrun = 0.f;
            const int ntiles = (qb + 1) * 4;
            u32x4 kreg[3], vreg[2];
            const int srow = tid >> 3, scp = tid & 7;
            const bf16_t* knp = KN + (tok0 + srow) * 1024 + h * 128 + scp * 8;
            const bf16_t* krp = KR + (tok0 + srow) * 64 + scp * 8;
            const bf16_t* vtp = VT + ((tok0 >> 6) * 1024 + h * 128 + srow) * 64 + scp * 8;
            const int kdst = srow * AT_KP + scp * 16, vdst = AT_VOFF + srow * AT_VP + scp * 16;
#define AT_LOAD(t) do { const bf16_t* kn_ = knp + (size_t)(t) * 65536; kreg[0] = *(const u32x4*)(kn_); kreg[1] = *(const u32x4*)(kn_ + 64); kreg[2] = *(const u32x4*)(krp + (size_t)(t) * 4096); \
                        const bf16_t* vt_ = vtp + (size_t)(t) * 65536; vreg[0] = *(const u32x4*)(vt_); vreg[1] = *(const u32x4*)(vt_ + 4096); } while (0)
#define AT_STORE(buf) do { ldsp base_ = lds + (buf) * AT_BUF; *(LAS u32x4*)(base_ + kdst) = kreg[0]; *(LAS u32x4*)(base_ + kdst + 128) = kreg[1]; *(LAS u32x4*)(base_ + kdst + 256) = kreg[2]; \
                           lds_w8x2(base_ + vdst, vreg[0]); lds_w8x2(base_ + vdst + 64 * AT_VP, vreg[1]); } while (0)
            AT_LOAD(0); AT_STORE(0); __syncthreads();
#pragma unroll 1
            for (int t = 0; t < ntiles; ++t) {
                const int buf = t & 1, key0 = t * 64;
                if (t + 1 < ntiles) AT_LOAD(t + 1);
                if (key0 <= q0 + 31) {
                    ldsp Lb = lds + buf * AT_BUF;
                    f32x16 s0, s1;
#pragma unroll
                    for (int r = 0; r < 16; ++r) { s0[r] = 0.f; s1[r] = 0.f; }
                    ldsp kb = Lb + l31 * AT_KP + hh * 16;
                    bf16x8 kf[6];
#pragma unroll
                    for (int i = 0; i < 6; ++i) kf[i] = *(const LAS bf16x8*)(kb + (i & 1) * 32 * AT_KP + (i >> 1) * 32);
#pragma unroll
                    for (int i = 0; i < 24; ++i) { const bf16x8 cur = kf[i % 6];
                        if (i + 6 < 24) kf[i % 6] = *(const LAS bf16x8*)(kb + ((i + 6) & 1) * 32 * AT_KP + ((i + 6) >> 1) * 32);
                        if (i & 1) s1 = MFMA32(cur, qf[i >> 1], s1); else s0 = MFMA32(cur, qf[i >> 1], s0); }
#pragma unroll
                    for (int i = 0; i < 6; ++i) __builtin_amdgcn_sched_group_barrier(0x100, 1, 0);
#pragma unroll
                    for (int i = 0; i < 18; ++i) { __builtin_amdgcn_sched_group_barrier(0x008, 1, 0); __builtin_amdgcn_sched_group_barrier(0x100, 1, 0); }
#pragma unroll
                    for (int i = 0; i < 6; ++i) __builtin_amdgcn_sched_group_barrier(0x008, 1, 0);
                    if (key0 + 63 > q0) {
                        const int qpos = q0 + l31;
#pragma unroll
                        for (int r = 0; r < 16; ++r) { const int key = key0 + crow(r, hh); if (key > qpos) s0[r] = -1e30f; if (key + 32 > qpos) s1[r] = -1e30f; }
                    }
                    float mx = s0[0];
#pragma unroll
                    for (int r = 1; r < 16; ++r) mx = fmaxf(mx, s0[r]);
#pragma unroll
                    for (int r = 0; r < 16; ++r) mx = fmaxf(mx, s1[r]);
                    { auto t_ = __builtin_amdgcn_permlane32_swap(__float_as_uint(mx), __float_as_uint(mx), false, false); mx = fmaxf(__uint_as_float(t_[0]), __uint_as_float(t_[1])); }
                    if (__builtin_amdgcn_ballot_w64(mx - mrun > 8.0f) != 0ull) {
                        const float mn = fmaxf(mrun, mx), al = __builtin_amdgcn_exp2f(mrun - mn); mrun = mn; lrun *= al;
#pragma unroll
                        for (int d = 0; d < 4; ++d)
#pragma unroll
                            for (int r = 0; r < 16; ++r) o[d][r] *= al;
                    }
                    float rs = 0.f;
#pragma unroll
                    for (int r = 0; r < 16; ++r) { s0[r] = __builtin_amdgcn_exp2f(s0[r] - mrun); s1[r] = __builtin_amdgcn_exp2f(s1[r] - mrun); rs += s0[r] + s1[r]; }
                    lrun += rs;
                    bf16x8 pa[2][2];
                    pa[0][0] = pack8(s0, 0); pa[0][1] = pack8(s0, 1); pa[1][0] = pack8(s1, 0); pa[1][1] = pack8(s1, 1);
#pragma unroll
                    for (int kb2 = 0; kb2 < 2; ++kb2)
#pragma unroll
                        for (int s2 = 0; s2 < 2; ++s2)
#pragma unroll
                            for (int d = 0; d < 4; ++d) {
                                const bf16x8 va = lds_8x2(Lb + AT_VOFF + (d * 32 + l31) * AT_VP + (kb2 * 32 + 16 * s2 + 4 * hh) * 2, 16);
                                o[d] = MFMA32(va, pa[kb2][s2], o[d]); }
                }
                if (t + 1 < ntiles) AT_STORE(buf ^ 1);
                __syncthreads();
            }
#undef AT_LOAD
#undef AT_STORE
            lrun += __shfl_xor(lrun, 32);
            const float inv = 1.0f / lrun;
            bf16_t* op = O + (tok0 + q0 + l31) * 1024 + h * 128 + 4 * hh;
#pragma unroll
            for (int d = 0; d < 4; ++d)
#pragma unroll
                for (int g = 0; g < 4; ++g) { u32x2 w; w.x = pk2(o[d][4 * g] * inv, o[d][4 * g + 1] * inv); w.y = pk2(o[d][4 * g + 2] * inv, o[d][4 * g + 3] * inv);
                    *(u32x2*)(op + d * 32 + 8 * g) = w; }
        }
    }
}
DI void hgrn_prep(ldsp lds, const float* LOGF, bf16_t* HQ, bf16_t* HK, bf16_t* KHT, float* DEC, int vcu, int G) {
    int tid_ = threadIdx.x; asm volatile("" : "+v"(tid_));
    const int tid = tid_, tg = tid >> 6, cl = tid & 63;
    LAS float* part = (LAS float*)lds;
    int par = 0;
    float lf[8], nlf[8]; unsigned short qv[8], kv[8], nqv[8], nkv[8];
#define HP_LOAD(it_, L, Q_, K_) do { const int cgi_ = (it_) >> 4, col_ = ((it_) & 15) * 64 + cl; const size_t b_ = ((size_t)cgi_ * 64 + 8 * tg) * 1024 + col_; \
        _Pragma("unroll") for (int tt = 0; tt < 8; ++tt) { L[tt] = LOGF[b_ + (size_t)tt * 1024]; Q_[tt] = HQ[b_ + (size_t)tt * 1024]; K_[tt] = HK[b_ + (size_t)tt * 1024]; } } while (0)
    if (vcu < 16384) HP_LOAD(vcu, lf, qv, kv);
#pragma unroll 1
    for (int it = vcu; it < 16384; it += G) {
        const int cgi = it >> 4, col = (it & 15) * 64 + cl; const size_t base = ((size_t)cgi * 64 + 8 * tg) * 1024 + col;
        const bool has_next = it + G < 16384;
        if (has_next) HP_LOAD(it + G, nlf, nqv, nkv);
#pragma unroll
        for (int tt = 1; tt < 8; ++tt) lf[tt] += lf[tt - 1];
        part[par * 512 + tg * 64 + cl] = lf[7];
        __syncthreads();
        float off = 0.f, gl = 0.f;
#pragma unroll
        for (int g2 = 0; g2 < 8; ++g2) { const float v = part[par * 512 + g2 * 64 + cl]; gl += v; if (g2 < tg) off += v; }
        float khv[8];
#pragma unroll
        for (int tt = 0; tt < 8; ++tt) { const float g = off + lf[tt]; const float q = bf2f(qv[tt]), k = bf2f(kv[tt]); const size_t idx = base + (size_t)tt * 1024;
            HQ[idx] = f2bf(q * __expf(g)); HK[idx] = f2bf(k * __expf(-g)); khv[tt] = k * __expf(gl - g); }
        u32x4 w; w.x = pk2(khv[0], khv[1]); w.y = pk2(khv[2], khv[3]); w.z = pk2(khv[4], khv[5]); w.w = pk2(khv[6], khv[7]);
        *(u32x4*)(KHT + (((size_t)cgi * 8 + (col >> 7)) * 128 + (col & 127)) * 64 + 8 * tg) = w;
        if (tg == 0) DEC[(size_t)cgi * 1024 + col] = __expf(gl);
        par ^= 1;
        if (has_next) {
#pragma unroll
            for (int tt = 0; tt < 8; ++tt) { lf[tt] = nlf[tt]; qv[tt] = nqv[tt]; kv[tt] = nkv[tt]; }
        }
    }
#undef HP_LOAD
}
constexpr int HS_QT = 0, HS_KT = 17408, HS_KHT = 34816, HS_VT = 52224, HS_DEC = 56576, HS_BUF = 57344, HS_QP = 272, HS_P = 136, HS_RED = 2 * HS_BUF;
static_assert(HS_RED + 32768 <= 147456, "scan LDS");
DI void hgrn_scan(ldsp lds, const bf16_t* QT, const bf16_t* KT, const bf16_t* KHT, const bf16_t* HVT, const float* DEC, bf16_t* HO, int vcu, int G) {
    int tid_ = threadIdx.x; asm volatile("" : "+v"(tid_));
    const int tid = tid_, wid = __builtin_amdgcn_readfirstlane(tid >> 6), lane = tid & 63, l31 = lane & 31, hh = lane >> 5;
    for (int it = vcu; it < 256; it += G) {
        const int bh = it >> 2, es = it & 3, b = bh >> 3, h = bh & 7;
        const size_t row00 = (size_t)b * SEQ;
        f32x16 st;
#pragma unroll
        for (int r = 0; r < 16; ++r) st[r] = 0.f;
        u32x4 rqA[2], rkA[2], rhA[2], rvA, rdA;
        const int p0 = tid, p1 = tid + 512;
        const bf16_t* qsrc0 = QT + (row00 + (p0 >> 4)) * 1024 + h * 128 + (p0 & 15) * 8; const bf16_t* qsrc1 = QT + (row00 + (p1 >> 4)) * 1024 + h * 128 + (p1 & 15) * 8;
        const bf16_t* ksrc0 = KT + (row00 + (p0 >> 4)) * 1024 + h * 128 + (p0 & 15) * 8; const bf16_t* ksrc1 = KT + (row00 + (p1 >> 4)) * 1024 + h * 128 + (p1 & 15) * 8;
        const int qd0 = (p0 >> 4) * HS_QP + (p0 & 15) * 16, qd1 = (p1 >> 4) * HS_QP + (p1 & 15) * 16;
        const bf16_t* hsrc0 = KHT + (((size_t)b * 128 * 8 + h) * 128 + (p0 >> 3)) * 64 + (p0 & 7) * 8; const bf16_t* hsrc1 = KHT + (((size_t)b * 128 * 8 + h) * 128 + (p1 >> 3)) * 64 + (p1 & 7) * 8;
        const int hd0 = HS_KHT + (p0 >> 3) * HS_P + (p0 & 7) * 16, hd1 = HS_KHT + (p1 >> 3) * HS_P + (p1 & 7) * 16;
        const int tv = tid & 255;
        const bf16_t* vsrc = HVT + ((row00 >> 6) * 1024 + h * 128 + es * 32 + (tv >> 3)) * 64 + (tv & 7) * 8; const int vd = HS_VT + (tv >> 3) * HS_P + (tv & 7) * 16;
        const int td = tid & 31;
        const float* dsrc = DEC + (size_t)b * 128 * 1024 + h * 128 + td * 4; const int dd = HS_DEC + td * 16;
#define HS_LOAD(c, X) do { rq##X[0] = *(const u32x4*)(qsrc0 + (size_t)(c) * 65536); rq##X[1] = *(const u32x4*)(qsrc1 + (size_t)(c) * 65536); \
        rk##X[0] = *(const u32x4*)(ksrc0 + (size_t)(c) * 65536); rk##X[1] = *(const u32x4*)(ksrc1 + (size_t)(c) * 65536); \
        rh##X[0] = *(const u32x4*)(hsrc0 + (size_t)(c) * 65536); rh##X[1] = *(const u32x4*)(hsrc1 + (size_t)(c) * 65536); \
        if (tid < 256) rv##X = *(const u32x4*)(vsrc + (size_t)(c) * 65536); else if (tid < 288) rd##X = *(const u32x4*)(dsrc + (size_t)(c) * 1024); } while (0)
#define HS_STORE(buf, X) do { ldsp B_ = lds + (buf) * HS_BUF; *(LAS u32x4*)(B_ + HS_QT + qd0) = rq##X[0]; *(LAS u32x4*)(B_ + HS_QT + qd1) = rq##X[1]; \
        *(LAS u32x4*)(B_ + HS_KT + qd0) = rk##X[0]; *(LAS u32x4*)(B_ + HS_KT + qd1) = rk##X[1]; lds_w8x2(B_ + hd0, rh##X[0]); lds_w8x2(B_ + hd1, rh##X[1]); \
        if (tid < 256) lds_w8x2(B_ + vd, rv##X); else if (tid < 288) *(LAS u32x4*)(B_ + dd) = rd##X; } while (0)
        HS_LOAD(0, A); HS_STORE(0, A); __syncthreads();
        const int tb = wid >> 2, db = wid & 3;
        LAS float* red = (LAS float*)(lds + HS_RED);
#pragma unroll 1
        for (int c2 = 0; c2 < 128; c2 += 2) {
            { const int c = c2, buf = 0;
              HS_LOAD(c + 1, A);
            ldsp Lb = lds + buf * HS_BUF;
            ldsp qb_ = Lb + HS_QT + (tb * 32 + l31) * HS_QP + db * 64 + hh * 16; ldsp kb_ = Lb + HS_KT + l31 * HS_QP + db * 64 + hh * 16;
            ldsp qr_ = Lb + HS_QT + (tb * 32 + l31) * HS_QP + 8 * hh + db * 64; ldsp vr_ = Lb + HS_VT + l31 * HS_P + 8 * hh;
            const bf16x8 qv0 = *(const LAS bf16x8*)(qb_), qv1 = *(const LAS bf16x8*)(qb_ + 32), k00 = *(const LAS bf16x8*)(kb_), k01 = *(const LAS bf16x8*)(kb_ + 32);
            const bf16x8 qa0 = lds_8x2(qr_, 16), qa1 = lds_8x2(qr_ + 32, 16), v00 = lds_8x2(vr_, 16), v01 = lds_8x2(vr_ + 32, 16);
            bf16x8 k10 = k00, k11 = k01, v10 = v00, v11 = v01;
            if (tb == 1) { k10 = *(const LAS bf16x8*)(kb_ + 32 * HS_QP); k11 = *(const LAS bf16x8*)(kb_ + 32 * HS_QP + 32); v10 = lds_8x2(vr_ + 64, 16); v11 = lds_8x2(vr_ + 96, 16); }
            __builtin_amdgcn_sched_barrier(0);
            f32x16 a0, o;
#pragma unroll
            for (int r = 0; r < 16; ++r) { a0[r] = 0.f; o[r] = 0.f; }
            a0 = MFMA32(k00, qv0, a0); a0 = MFMA32(k01, qv1, a0);
            o = MFMA32(qa0, pack8(st, 0), o); o = MFMA32(qa1, pack8(st, 1), o);
            { const float z0 = (tb == 0) ? 0.f : 1.f;
#pragma unroll
              for (int r = 0; r < 16; ++r) a0[r] *= (crow(r, hh) <= l31) ? 1.f : z0; }
            o = MFMA32(pack8(a0, 0), v00, o); o = MFMA32(pack8(a0, 1), v01, o);
            if (tb == 1) {
#pragma unroll
                for (int r = 0; r < 16; ++r) a0[r] = 0.f;
                a0 = MFMA32(k10, qv0, a0); a0 = MFMA32(k11, qv1, a0);
#pragma unroll
                for (int r = 0; r < 16; ++r) a0[r] *= (crow(r, hh) <= l31) ? 1.f : 0.f;
                o = MFMA32(pack8(a0, 0), v10, o); o = MFMA32(pack8(a0, 1), v11, o);
            }
            bf16x8 ka[4], vb[4];
#pragma unroll
            for (int ks = 0; ks < 4; ++ks) { ka[ks] = lds_8x2(Lb + HS_KHT + (db * 32 + l31) * HS_P + (ks * 16 + hh * 8) * 2, 8); vb[ks] = lds_8x2(Lb + HS_VT + l31 * HS_P + (ks * 16 + hh * 8) * 2, 8); }
            __builtin_amdgcn_sched_barrier(0);
            __syncthreads();
#pragma unroll
            for (int r = 0; r < 16; ++r) red[wid * 1024 + r * 64 + lane] = o[r];
#pragma unroll
            for (int r = 0; r < 16; ++r) st[r] *= *(const LAS float*)(Lb + HS_DEC + (db * 32 + crow(r, hh)) * 4);
#pragma unroll
            for (int ks = 0; ks < 4; ++ks) st = MFMA32(ka[ks], vb[ks], st);
            HS_STORE(1, A);
            __syncthreads();
            { bf16_t* op = HO + (row00 + (size_t)c * 64 + tb * 32 + 8 * db + 4 * hh) * 1024 + h * 128 + es * 32 + l31;
#pragma unroll
              for (int i = 0; i < 4; ++i) { const int ro = (4 * db + i) * 64 + lane; const float v = (red[(tb * 4 + 0) * 1024 + ro] + red[(tb * 4 + 1) * 1024 + ro]) + (red[(tb * 4 + 2) * 1024 + ro] + red[(tb * 4 + 3) * 1024 + ro]);
                  op[(size_t)i * 1024] = f2bf(v); } }
            }
            { const int c = c2 + 1, buf = 1;
              if (c + 1 < 128) HS_LOAD(c + 1, A);
            ldsp Lb = lds + buf * HS_BUF;
            ldsp qb_ = Lb + HS_QT + (tb * 32 + l31) * HS_QP + db * 64 + hh * 16; ldsp kb_ = Lb + HS_KT + l31 * HS_QP + db * 64 + hh * 16;
            ldsp qr_ = Lb + HS_QT + (tb * 32 + l31) * HS_QP + 8 * hh + db * 64; ldsp vr_ = Lb + HS_VT + l31 * HS_P + 8 * hh;
            const bf16x8 qv0 = *(const LAS bf16x8*)(qb_), qv1 = *(const LAS bf16x8*)(qb_ + 32), k00 = *(const LAS bf16x8*)(kb_), k01 = *(const LAS bf16x8*)(kb_ + 32);
            const bf16x8 qa0 = lds_8x2(qr_, 16), qa1 = lds_8x2(qr_ + 32, 16), v00 = lds_8x2(vr_, 16), v01 = lds_8x2(vr_ + 32, 16);
            bf16x8 k10 = k00, k11 = k01, v10 = v00, v11 = v01;
            if (tb == 1) { k10 = *(const LAS bf16x8*)(kb_ + 32 * HS_QP); k11 = *(const LAS bf16x8*)(kb_ + 32 * HS_QP + 32); v10 = lds_8x2(vr_ + 64, 16); v11 = lds_8x2(vr_ + 96, 16); }
            __builtin_amdgcn_sched_barrier(0);
            f32x16 a0, o;
#pragma unroll
            for (int r = 0; r < 16; ++r) { a0[r] = 0.f; o[r] = 0.f; }
            a0 = MFMA32(k00, qv0, a0); a0 = MFMA32(k01, qv1, a0);
            o = MFMA32(qa0, pack8(st, 0), o); o = MFMA32(qa1, pack8(st, 1), o);
            { const float z0 = (tb == 0) ? 0.f : 1.f;
#pragma unroll
              for (int r = 0; r < 16; ++r) a0[r] *= (crow(r, hh) <= l31) ? 1.f : z0; }
            o = MFMA32(pack8(a0, 0), v00, o); o = MFMA32(pack8(a0, 1), v01, o);
            if (tb == 1) {
#pragma unroll
                for (int r = 0; r < 16; ++r) a0[r] = 0.f;
                a0 = MFMA32(k10, qv0, a0); a0 = MFMA32(k11, qv1, a0);
#pragma unroll
                for (int r = 0; r < 16; ++r) a0[r] *= (crow(r, hh) <= l31) ? 1.f : 0.f;
                o = MFMA32(pack8(a0, 0), v10, o); o = MFMA32(pack8(a0, 1), v11, o);
            }
            bf16x8 ka[4], vb[4];
#pragma unroll
            for (int ks = 0; ks < 4; ++ks) { ka[ks] = lds_8x2(Lb + HS_KHT + (db * 32 + l31) * HS_P + (ks * 16 + hh * 8) * 2, 8); vb[ks] = lds_8x2(Lb + HS_VT + l31 * HS_P + (ks * 16 + hh * 8) * 2, 8); }
            __builtin_amdgcn_sched_barrier(0);
            __syncthreads();
#pragma unroll
            for (int r = 0; r < 16; ++r) red[wid * 1024 + r * 64 + lane] = o[r];
#pragma unroll
            for (int r = 0; r < 16; ++r) st[r] *= *(const LAS float*)(Lb + HS_DEC + (db * 32 + crow(r, hh)) * 4);
#pragma unroll
            for (int ks = 0; ks < 4; ++ks) st = MFMA32(ka[ks], vb[ks], st);
            if (c + 1 < 128) HS_STORE(0, A);
            __syncthreads();
            { bf16_t* op = HO + (row00 + (size_t)c * 64 + tb * 32 + 8 * db + 4 * hh) * 1024 + h * 128 + es * 32 + l31;
#pragma unroll
              for (int i = 0; i < 4; ++i) { const int ro = (4 * db + i) * 64 + lane; const float v = (red[(tb * 4 + 0) * 1024 + ro] + red[(tb * 4 + 1) * 1024 + ro]) + (red[(tb * 4 + 2) * 1024 + ro] + red[(tb * 4 + 3) * 1024 + ro]);
                  op[(size_t)i * 1024] = f2bf(v); } }
            }
        }
#undef HS_LOAD
#undef HS_STORE
    }
}
DI void hgrn_norm(const bf16_t* HO, const bf16_t* HG, const float* gn, bf16_t* HA, int gw, int NGW, int lane) {
    float gv[16];
#pragma unroll
    for (int j = 0; j < 16; ++j) gv[j] = gn[16 * lane + j];
    for (int row = gw; row < MTOK; row += 4 * NGW) {
        u32x4 a[4][2], g[4][2];
#pragma unroll
        for (int k = 0; k < 4; ++k) { const int rr = row + k * NGW; if (rr < MTOK) { const size_t idx = (size_t)rr * 1024 + 16 * lane;
            a[k][0] = *(const u32x4*)(HO + idx); a[k][1] = *(const u32x4*)(HO + idx + 8); g[k][0] = *(const u32x4*)(HG + idx); g[k][1] = *(const u32x4*)(HG + idx + 8); } }
#pragma unroll
        for (int k = 0; k < 4; ++k) { const int rr = row + k * NGW; if (rr < MTOK) { const size_t idx = (size_t)rr * 1024 + 16 * lane;
            f32x4 v[4], gg[4]; unpack8(a[k][0], v[0], v[1]); unpack8(a[k][1], v[2], v[3]); unpack8(g[k][0], gg[0], gg[1]); unpack8(g[k][1], gg[2], gg[3]);
            float ss = 0.f;
#pragma unroll
            for (int q = 0; q < 4; ++q) ss += (v[q][0] * v[q][0] + v[q][1] * v[q][1]) + (v[q][2] * v[q][2] + v[q][3] * v[q][3]);
            ss += __shfl_xor(ss, 1); ss += __shfl_xor(ss, 2); ss += __shfl_xor(ss, 4);
            const float rstd = rsqrtf(ss * (1.0f / 128.0f) + RMS_EPS);
            f32x4 o[4];
#pragma unroll
            for (int q = 0; q < 4; ++q)
#pragma unroll
                for (int j = 0; j < 4; ++j) o[q][j] = v[q][j] * rstd * gv[4 * q + j] * gg[q][j];
            *(u32x4*)(HA + idx) = pk8(o[0], o[1]); *(u32x4*)(HA + idx + 8) = pk8(o[2], o[3]); } }
    }
}
#define XB_TMO      128
#define XB_XCNT(j)  (256  + 64 * (j))
#define XB_XSUB(j)  (1280 + 64 * (j))
#define XB_XGEN(j)  (2304 + 64 * (j))
#define XB_TOP      3328
#define XB_TOPGEN   3392
#define XCD_BAR_WORDS 3456
#define XB_SPIN_CAP (1u << 18)

__device__ __forceinline__ unsigned xb_ld(unsigned* p)              { return __hip_atomic_load(p, __ATOMIC_RELAXED, __HIP_MEMORY_SCOPE_AGENT); }
__device__ __forceinline__ unsigned xb_add(unsigned* p, unsigned v) { return __hip_atomic_fetch_add(p, v, __ATOMIC_RELAXED, __HIP_MEMORY_SCOPE_AGENT); }
__device__ __forceinline__ unsigned xb_xcc_id() { return (unsigned)__builtin_amdgcn_s_getreg((3 << 11) | 20) & 0xFu; }
#define XB_SPIN(cond, bar) do { unsigned _sp = 0; while (cond) { __builtin_amdgcn_s_sleep(1); \
    if ((++_sp & 255u) == 0u) { if (xb_ld(&(bar)[XB_TMO])) break; if (_sp > XB_SPIN_CAP) { atomicAdd(&(bar)[XB_TMO], 1u); break; } } } } while (0)

struct XcdBarrier {
    unsigned* bar; unsigned x;
    volatile LAS unsigned* st;
};

__device__ __forceinline__ XcdBarrier xcd_barrier_post(unsigned* bar, volatile LAS unsigned* st) {
    XcdBarrier b; b.bar = bar; b.x = xb_xcc_id(); b.st = st;
    if (threadIdx.x == 0) (void)xb_add(&bar[XB_XCNT(b.x)], 1u);
    return b;
}
__device__ __forceinline__ void xcd_barrier_complete(unsigned* bar, unsigned x, unsigned& nloc, unsigned& nx) {
    const unsigned G = gridDim.x * gridDim.y * gridDim.z;
    unsigned sum, cnt, mine, sp = 0u;
    for (;;) {
        sum = 0u; cnt = 0u; mine = 0u;
#pragma unroll
        for (unsigned j = 0; j < 16; ++j) { const unsigned c = xb_ld(&bar[XB_XCNT(j)]); sum += c; cnt += (c > 0u) ? 1u : 0u; mine = (j == x) ? c : mine; }
        if (sum == G) break;
        __builtin_amdgcn_s_sleep(1);
        if ((++sp & 255u) == 0u) { if (xb_ld(&bar[XB_TMO])) break; if (sp > XB_SPIN_CAP) { atomicAdd(&bar[XB_TMO], 1u); break; } }
    }
    nloc = mine > 0u ? mine : 1u; nx = cnt > 0u ? cnt : 1u;
}

__device__ __forceinline__ void xcd_barrier(const XcdBarrier& b) {
    asm volatile("s_waitcnt vmcnt(0)" ::: "memory");
    __syncthreads();
    if (threadIdx.x == 0) {
        unsigned* bar = b.bar;
        __builtin_amdgcn_s_waitcnt(0);
        unsigned nloc = b.st[0], nx = b.st[1];
        if (nloc == 0u) { xcd_barrier_complete(bar, b.x, nloc, nx); b.st[0] = nloc; b.st[1] = nx; }
        const unsigned old = xb_add(&bar[XB_XSUB(b.x)], 1u);
        const unsigned gen = old / nloc;
        if (old + 1u == (gen + 1u) * nloc) {
            __builtin_amdgcn_fence(__ATOMIC_RELEASE, "agent");
            asm volatile("s_waitcnt vmcnt(0)" ::: "memory");
            const unsigned og = xb_add(&bar[XB_TOP], 1u);
            const unsigned tg = og / nx;
            if (og + 1u == (tg + 1u) * nx) xb_add(&bar[XB_TOPGEN], 1u);
            else XB_SPIN(xb_ld(&bar[XB_TOPGEN]) == tg, bar);
            __builtin_amdgcn_fence(__ATOMIC_ACQUIRE, "agent");
            xb_add(&bar[XB_XGEN(b.x)], 1u);
            asm volatile("s_waitcnt vmcnt(0)" ::: "memory");
        } else {
            XB_SPIN(xb_ld(&bar[XB_XGEN(b.x)]) == gen, bar);
            __builtin_amdgcn_fence(__ATOMIC_ACQUIRE, "agent");
            asm volatile("s_waitcnt vmcnt(0)" ::: "memory");
        }
    }
    __syncthreads();
}

struct Args { const void* in[21]; float* out; unsigned char* ws; int ph_lo, ph_hi; };
constexpr int N_PHASES = 20;

template <class Epi> DI void run_gemm(ldsp lds, const bf16_t* A, const bf16_t* Bt, int M, int N, int K, const Epi& E) {
    asm volatile("" : "+s"(M), "+s"(N), "+s"(K));
    pg8::Gemm g{A, Bt, M, N, K}; pg8::StaticOrder S; S.init(M, N, (int)gridDim.x, (int)blockIdx.x);
    pg8::gemm_phase<Epi, pg8::StaticOrder, true, true>(lds, g, S, E);
}

__global__ void __launch_bounds__(512, 2) mk_fwd(Args args) {
    extern __shared__ __attribute__((aligned(16))) unsigned char lds_raw[];
    ldsp lds = (ldsp)lds_raw;
    cg::grid_group grid = cg::this_grid();
    const int tid = threadIdx.x, lane = tid & 63, wave = __builtin_amdgcn_readfirstlane(tid >> 6);
    const int G = gridDim.x, bx = blockIdx.x, vcu = (G % 8 == 0) ? (bx % 8) * (G / 8) + bx / 8 : bx;
    const int gw = vcu * 8 + wave, NGW = G * 8;
    const size_t gt = (size_t)bx * 512 + tid, NGT = (size_t)G * 512;
    const int lo = args.ph_lo, hi = args.ph_hi;
    volatile LAS unsigned* xst = (volatile LAS unsigned*)(lds + 147456);
    if (tid < 2) xst[tid] = 0u;
    __syncthreads();
    XcdBarrier xbar = xcd_barrier_post((unsigned*)(args.ws + 512 * 1024), xst);
    unsigned char* ws = args.ws; unsigned char* dout = (unsigned char*)args.out;
    const float* x_in = (const float*)args.in[0]; const float* p_in = (const float*)args.in[1]; const int* pos = (const int*)args.in[2];
    bf16_t* WB = (bf16_t*)(ws + WS_W);
    bf16_t* PB = (bf16_t*)(ws + WS_PB); bf16_t* XB = (bf16_t*)(ws + WS_XB); float* XF = (float*)(ws + WS_XF); bf16_t* XB2 = (bf16_t*)(ws + WS_XB2);
    float* YW = (float*)(ws + WS_Y); float* YD = (float*)dout; bf16_t* PP = (bf16_t*)(ws + WS_PP); bf16_t* H = (bf16_t*)(ws + WS_H);
    bf16_t* Qb = (bf16_t*)(ws + WS_Q); bf16_t* DQ = (bf16_t*)(ws + WS_DQ); bf16_t* DKV = (bf16_t*)(ws + WS_DKV); bf16_t* KN = (bf16_t*)(ws + WS_KN); bf16_t* VT = (bf16_t*)(ws + WS_VT);
    bf16_t* Ob = (bf16_t*)(dout + DO_O); bf16_t* KR = (bf16_t*)(dout + DO_KR); float* SSQ = (float*)(dout + DO_SSQ);
    bf16_t* HQ = (bf16_t*)(ws + WS_HQ); float* LOGF = (float*)(ws + WS_LOGF); bf16_t* HK = (bf16_t*)(ws + WS_HK); bf16_t* HVT = (bf16_t*)(dout + DO_HVT); bf16_t* HG = (bf16_t*)(dout + DO_HG);
    bf16_t* KHT = (bf16_t*)(ws + WS_KHT); float* DEC = (float*)(ws + WS_DEC); bf16_t* HO = (bf16_t*)(ws + WS_HO); bf16_t* HA = (bf16_t*)(dout + DO_HA);
    f32x2v* ST1 = (f32x2v*)(ws + WS_ST1); f32x2v* ST2 = (f32x2v*)(ws + WS_ST2); float* CTLF = (float*)ws; float* PART = (float*)(ws + WS_PART);
    const float* lnmg = (const float*)args.in[15]; const float* lnmb = (const float*)args.in[16]; const float* lnfg = (const float*)args.in[17]; const float* lnfb = (const float*)args.in[18];
#ifndef SKIPMASK
#define SKIPMASK 0u
#endif
#define RUN(k) (lo <= (k) && (k) < hi && !((SKIPMASK >> (k)) & 1u))
#ifndef REPEATMASK
#define REPEATMASK 0u
#endif
#define REP(k) for (int rep_ = 0; rep_ < 1 + (int)((REPEATMASK >> (k)) & 1u); ++rep_)
#define RSYNC() do { if (rep_) grid.sync(); } while (0)
#define SEAM(k) do { if (RUN(k) && RUN((k) + 1)) { if ((k) == 0) grid.sync(); else xcd_barrier(xbar); } } while (0)

    if (RUN(0)) REP(0) { RSYNC();
        LAS float* scr = (LAS float*)(lds + wave * 16384);
        transpose_mat<MAT_DQKV>((const float*)args.in[3], 1024, 576, 768, WB + W_DQKV, nullptr, 1.f, scr, gw, NGW, lane);
        transpose_mat<MAT_UQ>((const float*)args.in[6], 256, 1536, 1536, WB + W_UQ, (const float*)args.in[4], QSCALE, scr, gw, NGW, lane);
        transpose_mat<MAT_UK>((const float*)args.in[7], 256, 2048, 1024, WB + W_UK, (const float*)args.in[5], 1.f, scr, gw, NGW, lane);
        transpose_mat<MAT_UV>((const float*)args.in[7], 256, 2048, 1024, WB + W_UV, (const float*)args.in[5], 1.f, scr, gw, NGW, lane);
        transpose_mat<MAT_ID>((const float*)args.in[8], 1024, 1024, 1024, WB + W_WO, nullptr, 1.f, scr, gw, NGW, lane);
        transpose_mat<MAT_HIN>((const float*)args.in[9], 1024, 4096, 4096, WB + W_HIN, nullptr, 1.f, scr, gw, NGW, lane);
        transpose_mat<MAT_ID>((const float*)args.in[12], 1024, 1024, 1024, WB + W_HO, nullptr, 1.f, scr, gw, NGW, lane);
        for (int i = 0; i < 2; ++i) {
            transpose_mat<MAT_FIN, true>((const float*)args.in[13] + (size_t)i * 1024 * 5632, 1024, 5632, 5632, WB + W_FIN + (size_t)i * 5632 * 1024, lnmg + i * 1024, 1.f, scr, gw, NGW, lane,
                                         lnmb + i * 1024, PART + P_FIN + (size_t)(i * 2 + 0) * 16 * 5632, PART + P_FIN + (size_t)(i * 2 + 1) * 16 * 5632);
            transpose_mat<MAT_ID>((const float*)args.in[14] + (size_t)i * 2816 * 1024, 2816, 1024, 1024, WB + W_FDN + (size_t)i * 1024 * 2816, nullptr, 1.f, scr, gw, NGW, lane);
            transpose_mat<MAT_ID>((const float*)args.in[19] + (size_t)i * 256 * 1024, 256, 1024, 1024, WB + W_PPJ + (size_t)i * 1024 * 256, nullptr, 1.f, scr, gw, NGW, lane);
            transpose_mat<MAT_ID, true>((const float*)args.in[20] + (size_t)i * 1024 * 1024, 1024, 1024, 1024, WB + W_PG + (size_t)i * 1024 * 1024, lnfg + i * 1024, 1.f, scr, gw, NGW, lane,
                                        lnfb + i * 1024, PART + P_PG + (size_t)(i * 2 + 0) * 16 * 1024, PART + P_PG + (size_t)(i * 2 + 1) * 16 * 1024);
        }
        cast_bf16(x_in, XB, (size_t)MTOK * 1024, gt, NGT);
        cast_bf16(p_in, PB, (size_t)2 * MTOK * 256, gt, NGT);
    }
    SEAM(0);
    if (RUN(1)) REP(1) { RSYNC();
        if (gt < 2 * (5632 + 1024)) {
            const int i = (int)gt; float c = 0.f, bsum = 0.f;
            if (i < 2 * 5632) { const int ly = i / 5632, n = i % 5632; const float* pc = PART + P_FIN + (size_t)(ly * 2) * 16 * 5632 + n; const float* pb = pc + 16 * 5632;
                for (int kb = 0; kb < 16; ++kb) { c += pc[kb * 5632]; bsum += pb[kb * 5632]; }
                CTLF[C_CSF + ly * 5632 + n] = c; CTLF[C_BWF + ly * 5632 + n] = bsum;
            } else { const int i2 = i - 2 * 5632, ly = i2 / 1024, n = i2 % 1024; const float* pc = PART + P_PG + (size_t)(ly * 2) * 16 * 1024 + n; const float* pb = pc + 16 * 1024;
                for (int kb = 0; kb < 16; ++kb) { c += pc[kb * 1024]; bsum += pb[kb * 1024]; }
                CTLF[C_CSG + ly * 1024 + n] = c; CTLF[C_BWG + ly * 1024 + n] = bsum; }
        }
        EpiDown E{DQ, DKV, KR, SSQ, pos}; run_gemm(lds, XB, WB + W_DQKV, MTOK, 768, 1024, E); }
    SEAM(1);
    if (RUN(2)) REP(2) { RSYNC();
#ifndef NO_P2A
        { EpiUQ E{Qb, SSQ, pos}; run_gemm(lds, DQ, WB + W_UQ, MTOK, 1536, 256, E); }
#endif
#ifndef NO_P2B
        { EpiUK E{KN, SSQ}; run_gemm(lds, DKV, WB + W_UK, MTOK, 1024, 256, E); }
#endif
#ifndef NO_P2C
        { EpiVT E{VT, SSQ}; run_gemm(lds, WB + W_UV, DKV, 1024, MTOK, 256, E); }
#endif
    }
    SEAM(2);
    if (RUN(3)) REP(3) { RSYNC(); attn_phase(lds, Qb, KN, KR, VT, Ob, vcu, G); }
    SEAM(3);
    if (RUN(4)) REP(4) { RSYNC(); EpiRes2<false, false> E{x_in, nullptr, nullptr, nullptr, XB, ST1}; run_gemm(lds, Ob, WB + W_WO, MTOK, 1024, 1024, E); }
    SEAM(4);
    if (RUN(6)) REP(6) { RSYNC();
        { EpiSwigluLN E{H, ST1, CTLF + C_CSF, CTLF + C_BWF}; run_gemm(lds, XB, WB + W_FIN, MTOK, 5632, 1024, E); }
        { EpiBf16<false> E{PP, 1024}; run_gemm(lds, PB, WB + W_PPJ, MTOK, 1024, 256, E); }
    }
    SEAM(6);
    if (RUN(7)) REP(7) { RSYNC(); EpiRes2<true, true> E{XB, ST1, lnmg, lnmb, XB, ST2}; run_gemm(lds, H, WB + W_FDN, MTOK, 1024, 2816, E); }
    SEAM(7);
    if (RUN(9)) REP(9) { RSYNC(); EpiGateLN E{XB, ST2, lnfg, lnfb, CTLF + C_CSG, CTLF + C_BWG, PP, nullptr, XB2}; run_gemm(lds, XB, WB + W_PG, MTOK, 1024, 1024, E); }
    SEAM(9);
    if (RUN(10)) REP(10) { RSYNC();
        { EpiHin E{HQ, HK, KHT, DEC, HG, (const float*)args.in[10]}; run_gemm(lds, XB2, WB + W_HIN, MTOK, 3072, 1024, E); }
        { EpiBf16<true> E{HVT, 65536}; run_gemm(lds, WB + W_HIN + (size_t)3072 * 1024, XB2, 1024, MTOK, 1024, E); }
    }
    SEAM(10);
    if (RUN(12)) REP(12) { RSYNC(); hgrn_scan(lds, HQ, HK, KHT, HVT, DEC, HO, vcu, G); }
    SEAM(12);
    if (RUN(13)) REP(13) { RSYNC(); hgrn_norm(HO, HG, (const float*)args.in[11], HA, gw, NGW, lane); }
    SEAM(13);
    if (RUN(14)) REP(14) { RSYNC(); EpiRes2<false, true> E{XB2, nullptr, nullptr, nullptr, XB, ST1}; run_gemm(lds, HA, WB + W_HO, MTOK, 1024, 1024, E); }
    SEAM(14);
    if (RUN(16)) REP(16) { RSYNC();
        { EpiSwigluLN E{H, ST1, CTLF + C_CSF + 5632, CTLF + C_BWF + 5632}; run_gemm(lds, XB, WB + W_FIN + (size_t)5632 * 1024, MTOK, 5632, 1024, E); }
        { EpiBf16<false> E{PP, 1024}; run_gemm(lds, PB + (size_t)MTOK * 256, WB + W_PPJ + (size_t)1024 * 256, MTOK, 1024, 256, E); }
    }
    SEAM(16);
    if (RUN(17)) REP(17) { RSYNC(); EpiRes2<true, true> E{XB, ST1, lnmg + 1024, lnmb + 1024, XB, ST2}; run_gemm(lds, H, WB + W_FDN + (size_t)1024 * 2816, MTOK, 1024, 2816, E); }
    SEAM(17);
    if (RUN(19)) REP(19) { RSYNC(); EpiGateLN E{XB, ST2, lnfg + 1024, lnfb + 1024, CTLF + C_CSG + 1024, CTLF + C_BWG + 1024, PP, YD, nullptr}; run_gemm(lds, XB, WB + W_PG + (size_t)1024 * 1024, MTOK, 1024, 1024, E); }
#undef RUN
#undef SEAM
}

#ifndef MK_MULTI
#define MK_MULTI 0
#endif
extern "C" void kernel_launch(void* const* d_in, const int* in_sizes, int n_in, void* d_out, int out_size, void* d_ws, size_t ws_size, hipStream_t stream) {
    static int grid = 0;
    if (grid == 0) {
        int dev = 0, cus = 0, per_cu = 0;
        hipGetDevice(&dev);
        hipDeviceGetAttribute(&cus, hipDeviceAttributeMultiprocessorCount, dev);
        hipFuncSetAttribute((const void*)mk_fwd, hipFuncAttributeMaxDynamicSharedMemorySize, LDS_BYTES);
        hipOccupancyMaxActiveBlocksPerMultiprocessor(&per_cu, (const void*)mk_fwd, 512, LDS_BYTES);
        if (per_cu < 1) { fprintf(stderr, "kernel_launch: occupancy query says %d blocks per CU\n", per_cu); per_cu = 1; }
        (void)hipGetLastError();
        grid = cus * 1;
        if (n_in != 21 || ws_size < 1024 * MiB) fprintf(stderr, "kernel_launch: unexpected n_in %d / ws_size %zu\n", n_in, ws_size);
    }
    Args a{};
    for (int i = 0; i < 21; ++i) a.in[i] = d_in[i];
    a.out = (float*)d_out; a.ws = (unsigned char*)d_ws;
#if MK_MULTI
    for (int k = 0; k < N_PHASES; ++k) { a.ph_lo = k; a.ph_hi = k + 1; hipLaunchKernelGGL(mk_fwd, dim3(grid), dim3(512), LDS_BYTES, stream, a); }
#else
    a.ph_lo = 0; a.ph_hi = N_PHASES;
    (void)hipMemsetAsync((unsigned char*)d_ws + 512 * 1024, 0, 16384, stream);
    void* kargs[] = {&a};
    hipError_t e = hipLaunchCooperativeKernel((const void*)mk_fwd, dim3(grid), dim3(512), kargs, LDS_BYTES, stream);
    if (e != hipSuccess) fprintf(stderr, "kernel_launch: cooperative launch failed: %s (grid %d)\n", hipGetErrorString(e), grid);
#endif
}
```

```cpp
#include <hip/hip_runtime.h>
#include <hip/hip_cooperative_groups.h>
#include <cstdio>
#include <cstdint>
namespace cg = cooperative_groups;

namespace pg8 {
#define PG8_LAS __attribute__((address_space(3)))
typedef unsigned short bf16_t;
typedef short bf16x8 __attribute__((ext_vector_type(8)));
typedef float f32x4 __attribute__((ext_vector_type(4)));
typedef unsigned u32x4 __attribute__((ext_vector_type(4)));
constexpr int BM = 256, BK = 64, HALF = 128, HTB = HALF * BK * 2  , STAGE_BYTES = 8 * HTB, NXCD = 8, WGM = 8;

__host__ __device__ __forceinline__ int lds_byte(int r, int c) { const int st = (r >> 4) * 2 + (c >> 5), rr = r & 15, cc = c & 31, ob = rr * 64 + cc * 2; return st * 1024 + (ob ^ (((ob >> 9) & 1) << 5)); }
__host__ __device__ __forceinline__ void stage_rc(int b, int& R, int& C) { const int st = b / 1024, sb = b % 1024, swz = sb ^ (((sb >> 9) & 1) << 5); R = (st >> 1) * 16 + swz / 64; C = (st & 1) * 32 + (swz % 64) / 2; }
__host__ __device__ __forceinline__ int perm32(int rho) { const int n = rho >> 4, i = rho & 15; return 8 * (i >> 2) + 4 * n + (i & 3); }

struct Unit { int pm, pn; };
struct Gemm { const bf16_t* A; const bf16_t* Bt; int M, N, K; };

struct StaticOrder {
    int nM, nN, nwg, G, c;
    __host__ __device__ void init(int M, int N, int G_, int c_) { nM = M / BM; nN = N / BM; nwg = nM * nN; G = G_; c = c_; }
    __host__ __device__ bool next(int i, Unit& u) const {
        const long L = (long)i * G + c; if (L >= nwg) return false;
        int wgid = (int)L; { const int q = nwg / NXCD, r = nwg % NXCD, xcd = wgid % NXCD, off = wgid / NXCD; wgid = (xcd < r ? xcd * (q + 1) : r * (q + 1) + (xcd - r) * q) + off; }
        const int nig = WGM * nN, gid = wgid / nig, fm = gid * WGM, gsz = (nM - fm) < WGM ? (nM - fm) : WGM;
        u.pm = fm + ((wgid % nig) % gsz); u.pn = (wgid % nig) / gsz; return true;
    }
    __device__ __forceinline__ void a_ready(const Unit&) const {}
    __device__ __forceinline__ void done(const Unit&) const {}
};

template <class Epi, class Sched, bool ALIGN_EPI = false, bool SP2 = false>
__device__ __forceinline__ void gemm_phase(PG8_LAS unsigned char* lds, const Gemm g, const Sched& S, const Epi& E) {
    int tid_ = threadIdx.x; asm volatile("" : "+v"(tid_));
    const int tid = tid_, wid = __builtin_amdgcn_readfirstlane(tid >> 6), lane = tid & 63, wr = wid >> 2, wc = wid & 3, fr = lane & 15, fq = lane >> 4;
    const int K = g.K, nt = K / BK;
    unsigned voffA[2], voffB[2];
#pragma unroll
    for (int i = 0; i < 2; ++i) { int R, C; stage_rc(tid * 16 + i * 8192, R, C); const int Rb = Epi::PERM ? ((R & ~31) + perm32(R & 31)) : R;
        voffA[i] = (unsigned)(R * K + C) * 2u; voffB[i] = (unsigned)(Rb * K + C) * 2u; }
    const size_t kstep = (size_t)(BK * 2);
    const size_t hstep = (size_t)HALF * K * 2;
    const size_t tstep = 2 * hstep;
    const unsigned ldsw = (unsigned)wid * 1024u;
    const int aoff = lds_byte(wr * 64 + fr, fq * 8), boff = lds_byte(wc * 32 + fr, fq * 8);
#define PG8_SA(b, h) (((b) * 2 + (h)) * HTB)
#define PG8_SB(b, h) ((4 + (b) * 2 + (h)) * HTB)
#define PG8_STAGE(bufoff, gbase, voff) do { _Pragma("unroll") for (int _i = 0; _i < 2; ++_i) \
        __builtin_amdgcn_global_load_lds((const unsigned*)((const char*)(gbase) + (voff)[_i]), (PG8_LAS unsigned*)(lds + (bufoff) + ldsw + _i * 8192), 16, 0, 0); } while (0)
#define PG8_LDA(dst, b, h) do { _Pragma("unroll") for (int m = 0; m < 4; ++m) _Pragma("unroll") for (int k = 0; k < 2; ++k) dst[m][k] = *(const PG8_LAS bf16x8*)(lds + PG8_SA(b, h) + aoff + m * 2048 + k * 1024); } while (0)
#define PG8_LDB(dst, b, h) do { _Pragma("unroll") for (int n = 0; n < 2; ++n) _Pragma("unroll") for (int k = 0; k < 2; ++k) dst[n][k] = *(const PG8_LAS bf16x8*)(lds + PG8_SB(b, h) + boff + n * 2048 + k * 1024); } while (0)
#define PG8_MMA(ai, bj, At, Bt) do { __builtin_amdgcn_s_setprio(1); _Pragma("unroll") for (int m = 0; m < 4; ++m) _Pragma("unroll") for (int n = 0; n < 2; ++n) _Pragma("unroll") for (int k = 0; k < 2; ++k) \
        acc[ai][bj][m][n] = __builtin_amdgcn_mfma_f32_16x16x32_bf16(Bt[n][k], At[m][k], acc[ai][bj][m][n], 0, 0, 0); __builtin_amdgcn_s_setprio(0); } while (0)
#define PG8_WAIT_V(n) asm volatile("s_waitcnt vmcnt(" #n ")" ::: "memory")
#define PG8_WAIT_L(n) asm volatile("s_waitcnt lgkmcnt(" #n ")" ::: "memory")
#define PG8_BAR __builtin_amdgcn_s_barrier()
#define PG8_SCHED __builtin_amdgcn_sched_barrier(0)
    Unit cur, nxt; int ui = 0;
    if (!S.next(0, cur)) return;
    f32x4 acc[2][2][4][2];
#pragma unroll
    for (int a = 0; a < 2; ++a)
#pragma unroll
        for (int b = 0; b < 2; ++b)
#pragma unroll
            for (int m = 0; m < 4; ++m)
#pragma unroll
                for (int n = 0; n < 2; ++n) acc[a][b][m][n] = (f32x4){0.f, 0.f, 0.f, 0.f};
    bf16x8 At[4][2], B0[2][2], B1[2][2];
    const char* cA = (const char*)g.A + (size_t)cur.pm * tstep; const char* cB = (const char*)g.Bt + (size_t)cur.pn * tstep;
    S.a_ready(cur);
    if constexpr (SP2) {
        PG8_STAGE(PG8_SB(0, 0), cB, voffB); PG8_STAGE(PG8_SB(0, 1), cB + hstep, voffB); PG8_STAGE(PG8_SA(0, 0), cA, voffA); PG8_STAGE(PG8_SA(0, 1), cA + hstep, voffA);
        if (wr == 1) PG8_BAR;
        PG8_WAIT_V(2); PG8_BAR;
        PG8_STAGE(PG8_SB(1, 0), cB + kstep, voffB); PG8_STAGE(PG8_SA(1, 0), cA + kstep, voffA); PG8_STAGE(PG8_SB(1, 1), cB + hstep + kstep, voffB);
        PG8_WAIT_V(6); PG8_BAR;
    } else {
        PG8_STAGE(PG8_SB(0, 0), cB, voffB); PG8_STAGE(PG8_SA(0, 0), cA, voffA); PG8_STAGE(PG8_SB(0, 1), cB + hstep, voffB); PG8_STAGE(PG8_SA(0, 1), cA + hstep, voffA);
        if (wr == 1) PG8_BAR;
        PG8_WAIT_V(4); PG8_BAR;
        PG8_STAGE(PG8_SB(1, 0), cB + kstep, voffB); PG8_STAGE(PG8_SA(1, 0), cA + kstep, voffA); PG8_STAGE(PG8_SB(1, 1), cB + hstep + kstep, voffB);
        PG8_WAIT_V(6); PG8_BAR;
    }
    for (;;) {
        const bool has_next = S.next(ui + 1, nxt);
        const char* nA = has_next ? (const char*)g.A + (size_t)nxt.pm * tstep : cA; const char* nB = has_next ? (const char*)g.Bt + (size_t)nxt.pn * tstep : cB;
        for (int t = 0; t < nt; t += 2) {
            const bool last = (t == nt - 2);
            const char* a1 = cA + (size_t)(t + 1) * kstep;
            const char* a2 = last ? nA : cA + (size_t)(t + 2) * kstep; const char* b2 = last ? nB : cB + (size_t)(t + 2) * kstep;
            const char* a3 = a2 + kstep; const char* b3 = b2 + kstep;
            if (last && has_next) S.a_ready(nxt);
            if constexpr (SP2) {
            PG8_LDB(B0, 0, 0); PG8_LDB(B1, 0, 1); PG8_SCHED; PG8_LDA(At, 0, 0); PG8_STAGE(PG8_SA(1, 1), a1 + hstep, voffA);
            PG8_WAIT_V(8); PG8_WAIT_L(0); PG8_BAR; PG8_MMA(0, 0, At, B0); PG8_MMA(0, 1, At, B1); PG8_BAR; PG8_SCHED;
            PG8_LDA(At, 0, 1); PG8_STAGE(PG8_SB(0, 0), b2, voffB); PG8_STAGE(PG8_SB(0, 1), b2 + hstep, voffB); PG8_STAGE(PG8_SA(0, 0), a2, voffA);
            PG8_WAIT_V(8); PG8_WAIT_L(0); PG8_BAR; PG8_MMA(1, 0, At, B0); PG8_MMA(1, 1, At, B1); PG8_BAR; PG8_SCHED;
            PG8_LDB(B0, 1, 0); PG8_LDB(B1, 1, 1); PG8_SCHED; PG8_LDA(At, 1, 0); PG8_STAGE(PG8_SA(0, 1), a2 + hstep, voffA);
            PG8_WAIT_V(8); PG8_WAIT_L(0); PG8_BAR; PG8_MMA(0, 0, At, B0); PG8_MMA(0, 1, At, B1); PG8_BAR; PG8_SCHED;
            PG8_LDA(At, 1, 1); PG8_STAGE(PG8_SB(1, 0), b3, voffB); PG8_STAGE(PG8_SB(1, 1), b3 + hstep, voffB); PG8_STAGE(PG8_SA(1, 0), a3, voffA);
            PG8_WAIT_V(8); PG8_WAIT_L(0); PG8_BAR; PG8_MMA(1, 0, At, B0); PG8_MMA(1, 1, At, B1); PG8_BAR; PG8_SCHED;
            } else {
            PG8_LDB(B0, 0, 0); PG8_SCHED; PG8_LDA(At, 0, 0); PG8_STAGE(PG8_SA(1, 1), a1 + hstep, voffA);
            PG8_WAIT_L(8); PG8_BAR; PG8_WAIT_L(0); PG8_MMA(0, 0, At, B0); PG8_BAR; PG8_SCHED;
            PG8_LDB(B1, 0, 1); PG8_STAGE(PG8_SB(0, 0), b2, voffB);
            PG8_BAR; PG8_WAIT_L(0); PG8_MMA(0, 1, At, B1); PG8_BAR;
            PG8_LDA(At, 0, 1); PG8_STAGE(PG8_SA(0, 0), a2, voffA);
            PG8_BAR; PG8_WAIT_L(0); PG8_MMA(1, 0, At, B0); PG8_BAR; PG8_SCHED;
            PG8_STAGE(PG8_SB(0, 1), b2 + hstep, voffB);
            PG8_WAIT_V(6); PG8_BAR; PG8_MMA(1, 1, At, B1); PG8_BAR;
            PG8_LDB(B0, 1, 0); PG8_SCHED; PG8_LDA(At, 1, 0); PG8_STAGE(PG8_SA(0, 1), a2 + hstep, voffA);
            PG8_WAIT_L(8); PG8_BAR; PG8_WAIT_L(0); PG8_MMA(0, 0, At, B0); PG8_BAR; PG8_SCHED;
            PG8_LDB(B1, 1, 1); PG8_STAGE(PG8_SB(1, 0), b3, voffB);
            PG8_BAR; PG8_WAIT_L(0); PG8_MMA(0, 1, At, B1); PG8_BAR;
            PG8_LDA(At, 1, 1); PG8_STAGE(PG8_SA(1, 0), a3, voffA);
            PG8_BAR; PG8_WAIT_L(0); PG8_MMA(1, 0, At, B0); PG8_BAR; PG8_SCHED;
            PG8_STAGE(PG8_SB(1, 1), b3 + hstep, voffB);
            PG8_WAIT_V(6); PG8_BAR; PG8_MMA(1, 1, At, B1); PG8_BAR;
            }
        }
        if constexpr (ALIGN_EPI) { if (wr == 0) PG8_BAR; }
        if constexpr (!Epi::AFTER_DRAIN) { E(acc, cur, wr, wc, fr, fq); S.done(cur); }
        if (!has_next) break;
#pragma unroll
        for (int a = 0; a < 2; ++a)
#pragma unroll
            for (int b = 0; b < 2; ++b)
#pragma unroll
                for (int m = 0; m < 4; ++m)
#pragma unroll
                    for (int n = 0; n < 2; ++n) acc[a][b][m][n] = (f32x4){0.f, 0.f, 0.f, 0.f};
        cur = nxt; cA = nA; cB = nB; ++ui;
        if constexpr (ALIGN_EPI) { if (wr == 1) PG8_BAR; }
    }
    PG8_WAIT_V(0);
    if constexpr (!ALIGN_EPI) { if (wr == 0) PG8_BAR; }
    PG8_BAR;
    if constexpr (Epi::AFTER_DRAIN) { E.fused(acc, cur, wr, wc, fr, fq, lds, wid, lane); S.done(cur); }
#undef PG8_SA
#undef PG8_SB
#undef PG8_STAGE
#undef PG8_LDA
#undef PG8_LDB
#undef PG8_MMA
#undef PG8_WAIT_V
#undef PG8_WAIT_L
#undef PG8_BAR
#undef PG8_SCHED
}
}
#define LAS __attribute__((address_space(3)))
typedef unsigned short bf16_t;
typedef short bf16x8 __attribute__((ext_vector_type(8)));
typedef short s16x4 __attribute__((ext_vector_type(4)));
typedef float f32x4 __attribute__((ext_vector_type(4)));
typedef float f32x16 __attribute__((ext_vector_type(16)));
typedef unsigned u32x4 __attribute__((ext_vector_type(4)));
typedef unsigned u32x2 __attribute__((ext_vector_type(2)));
typedef __bf16 bf16x2_t __attribute__((ext_vector_type(2)));
typedef float f32x2_t __attribute__((ext_vector_type(2)));
typedef LAS unsigned char* ldsp;

#define DI __device__ __forceinline__
DI unsigned pk2(float lo, float hi) { f32x2_t v = {lo, hi}; bf16x2_t b = __builtin_convertvector(v, bf16x2_t); return __builtin_bit_cast(unsigned, b); }
DI float bflo(unsigned u) { return __builtin_bit_cast(float, u << 16); }
DI float bfhi(unsigned u) { return __builtin_bit_cast(float, u & 0xffff0000u); }
DI float bf2f(bf16_t u) { return __builtin_bit_cast(float, (unsigned)u << 16); }
DI bf16_t f2bf(float f) { return (bf16_t)(pk2(f, 0.f) & 0xffffu); }
DI float sigmoidf_(float x) { return __builtin_amdgcn_rcpf(1.0f + __expf(-x)); }
DI float siluf_(float x) { return x * __builtin_amdgcn_rcpf(1.0f + __expf(-x)); }
DI int crow(int reg, int hh) { return (reg & 3) + 8 * (reg >> 2) + 4 * hh; }
#define MFMA32(a, b, c) __builtin_amdgcn_mfma_f32_32x32x16_bf16((a), (b), (c), 0, 0, 0)
DI bf16x8 pack8(const f32x16& x, int s) {
    u32x4 p; p.x = pk2(x[8 * s + 0], x[8 * s + 1]); p.y = pk2(x[8 * s + 2], x[8 * s + 3]); p.z = pk2(x[8 * s + 4], x[8 * s + 5]); p.w = pk2(x[8 * s + 6], x[8 * s + 7]);
    return __builtin_bit_cast(bf16x8, p);
}
DI bf16x8 lds_8x2(ldsp p, int gap) {
    s16x4 lo = *(const LAS s16x4*)p, hi = *(const LAS s16x4*)(p + gap);
    return __builtin_shufflevector(lo, hi, 0, 1, 2, 3, 4, 5, 6, 7);
}
DI void lds_w8x2(ldsp p, u32x4 v) { u32x2 a = {v.x, v.y}, b = {v.z, v.w}; *(LAS u32x2*)p = a; *(LAS u32x2*)(p + 8) = b; }
DI float wave_sum(float v) {
#pragma unroll
    for (int o = 1; o < 64; o <<= 1) v += __shfl_xor(v, o);
    return v;
}
DI void sincos_rad(float ang, float& s, float& c) {
    double r = (double)ang * 0.15915494309189535; r -= __builtin_rint(r); const float f = (float)r;
    s = __builtin_amdgcn_sinf(f); c = __builtin_amdgcn_cosf(f);
}

constexpr int BATCH = 8, SEQ = 8192, DM = 1024, MTOK = BATCH * SEQ;
constexpr int DFF = 2816, DPLE = 256;
constexpr float LN_EPS = 1e-5f, RMS_EPS = 1e-6f;
constexpr float ALPHA = 1.4142135623730951f;
constexpr float QSCALE = 0.07216878364870322f * 1.4426950408889634f;
constexpr size_t MiB = 1u << 20;
constexpr size_t WS_W = 1 * MiB, WS_DEC = 60 * MiB, WS_PB = 64 * MiB, WS_XB = 128 * MiB, WS_XF = 256 * MiB, WS_XB2 = 512 * MiB, WS_Y = 640 * MiB, WS_PP = 896 * MiB;
constexpr size_t WS_Q = 256 * MiB, WS_DQ = 448 * MiB, WS_DKV = 480 * MiB, WS_KN = 512 * MiB, WS_VT = 896 * MiB, WS_H = 512 * MiB;
constexpr size_t WS_HQ = 128 * MiB, WS_LOGF = 640 * MiB, WS_HK = 896 * MiB, WS_KHT = 256 * MiB, WS_HO = 640 * MiB, WS_HA = 768 * MiB;
constexpr size_t DO_O = 0, DO_KR = 128 * MiB, DO_SSQ = 136 * MiB, DO_HVT = 0, DO_HG = 128 * MiB, DO_HA = 0;
constexpr size_t WS_ST1 = 864 * MiB, WS_ST2 = 872 * MiB, WS_PART = 55 * MiB;
constexpr size_t C_CSF = 0, C_BWF = 2 * 5632, C_CSG = 4 * 5632, C_BWG = 4 * 5632 + 2 * 1024;
constexpr size_t P_FIN = 0, P_PG = 4 * 16 * 5632;
constexpr size_t W_DQKV = 0, W_UQ = W_DQKV + 768 * 1024, W_UK = W_UQ + 1536 * 256, W_UV = W_UK + 1024 * 256, W_WO = W_UV + 1024 * 256,
                 W_HIN = W_WO + 1024 * 1024, W_HO = W_HIN + 4096 * 1024, W_FIN = W_HO + 1024 * 1024, W_FDN = W_FIN + 2 * 5632 * 1024,
                 W_PPJ = W_FDN + 2 * 1024 * 2816, W_PG = W_PPJ + 2 * 1024 * 256, W_END = W_PG + 2 * 1024 * 1024;
static_assert(WS_W + W_END * 2 <= WS_DEC, "weights fit");
constexpr int LDS_BYTES = 147456 + 1024;
#define EPI_COMMON static constexpr bool PERM = true, AFTER_DRAIN = false;
#define EPI_SIG (const f32x4 (&acc)[2][2][4][2], const pg8::Unit& u, int wr, int wc, int fr, int fq) const
#define UNROLL _Pragma("unroll")
DI u32x4 pk8(const f32x4& a, const f32x4& b) { u32x4 w; w.x = pk2(a[0], a[1]); w.y = pk2(a[2], a[3]); w.z = pk2(b[0], b[1]); w.w = pk2(b[2], b[3]); return w; }
constexpr float ROPE_L2 = 0.4152410118609203f;

DI void rope_sc(float p, int i0, f32x4& s, f32x4& c) {
    UNROLL for (int j = 0; j < 4; ++j) { const float invf = exp2f(-(float)(i0 + j) * ROPE_L2); float sj, cj; sincos_rad(p * invf, sj, cj); s[j] = sj; c[j] = cj; }
}
DI u32x4 rope_apply(const f32x4& t1, const f32x4& t2, const f32x4& s, const f32x4& c) {
    const f32x4 o1 = t1 * c - t2 * s, o2 = t2 * c + t1 * s; return pk8(o1, o2);
}
struct EpiDown { EPI_COMMON bf16_t* DQ; bf16_t* DKV; bf16_t* KR; float* SSQ; const int* pos;
    DI void operator() EPI_SIG {
        const size_t row0 = (size_t)u.pm * 256 + wr * 64 + fr;
        if (u.pn < 2) {
            bf16_t* dst = u.pn == 0 ? DQ : DKV;
            UNROLL for (int ai = 0; ai < 2; ++ai) UNROLL for (int m = 0; m < 4; ++m) { const size_t row = row0 + ai * 128 + m * 16; float ss = 0.f;
                UNROLL for (int bj = 0; bj < 2; ++bj) { const f32x4 v0 = acc[ai][bj][m][0], v1 = acc[ai][bj][m][1];
                    ss += v0[0] * v0[0] + v0[1] * v0[1] + v0[2] * v0[2] + v0[3] * v0[3] + v1[0] * v1[0] + v1[1] * v1[1] + v1[2] * v1[2] + v1[3] * v1[3];
                    *(u32x4*)(dst + row * 256 + bj * 128 + wc * 32 + 8 * fq) = pk8(v0, v1); }
                ss += __shfl_xor(ss, 16); ss += __shfl_xor(ss, 32);
                if (fq == 0) SSQ[row * 8 + u.pn * 4 + wc] = ss; }
        } else if (wc < 2) {
            const int g = 4 * wc + fq;
            UNROLL for (int ai = 0; ai < 2; ++ai) UNROLL for (int m = 0; m < 4; ++m) { const size_t row = row0 + ai * 128 + m * 16;
                f32x4 sn, cs; rope_sc((float)pos[row], 4 * g, sn, cs); *(u32x4*)(KR + row * 64 + 8 * g) = rope_apply(acc[ai][0][m][0], acc[ai][0][m][1], sn, cs); }
        }
    }
};
struct EpiUQ { EPI_COMMON bf16_t* Q; const float* SSQ; const int* pos;
    DI void operator() EPI_SIG {
        const size_t row0 = (size_t)u.pm * 256 + wr * 64 + fr;
        float rsa[2][4];
        UNROLL for (int ai = 0; ai < 2; ++ai) UNROLL for (int m = 0; m < 4; ++m) { const f32x4 sq = *(const f32x4*)(SSQ + (row0 + ai * 128 + m * 16) * 8); rsa[ai][m] = rsqrtf((sq[0] + sq[1] + sq[2] + sq[3]) * (1.0f / 256.0f) + RMS_EPS); }
        UNROLL for (int ai = 0; ai < 2; ++ai) UNROLL for (int m = 0; m < 4; ++m) { const size_t row = row0 + ai * 128 + m * 16;
            const float rstd = rsa[ai][m];
            if (u.pn < 4) {
                UNROLL for (int bj = 0; bj < 2; ++bj) { const int h = 2 * u.pn + bj;
                    *(u32x4*)(Q + row * 1536 + h * 192 + wc * 32 + 8 * fq) = pk8(acc[ai][bj][m][0] * rstd, acc[ai][bj][m][1] * rstd); }
            } else {
                const int g = 4 * (wc & 1) + fq; f32x4 sn, cs; rope_sc((float)pos[row], 4 * g, sn, cs); sn = sn * rstd; cs = cs * rstd;
                UNROLL for (int bj = 0; bj < 2; ++bj) { const int cc = 256 * (u.pn - 4) + 128 * bj + 32 * wc, h = cc >> 6;
                    *(u32x4*)(Q + row * 1536 + h * 192 + 128 + 8 * g) = rope_apply(acc[ai][bj][m][0], acc[ai][bj][m][1], sn, cs); }
            }
        }
    }
};
struct EpiUK { EPI_COMMON bf16_t* O; const float* SSQ;
    DI void operator() EPI_SIG {
        const size_t row0 = (size_t)u.pm * 256 + wr * 64 + fr; const int col0 = u.pn * 256 + wc * 32 + 8 * fq;
        float rsa[2][4];
        UNROLL for (int ai = 0; ai < 2; ++ai) UNROLL for (int m = 0; m < 4; ++m) { const f32x4 sq = *(const f32x4*)(SSQ + (row0 + ai * 128 + m * 16) * 8 + 4); rsa[ai][m] = rsqrtf((sq[0] + sq[1] + sq[2] + sq[3]) * (1.0f / 256.0f) + RMS_EPS); }
        UNROLL for (int ai = 0; ai < 2; ++ai) UNROLL for (int m = 0; m < 4; ++m) { const size_t row = row0 + ai * 128 + m * 16;
            const float rstd = rsa[ai][m];
            UNROLL for (int bj = 0; bj < 2; ++bj) *(u32x4*)(O + row * 1024 + col0 + bj * 128) = pk8(acc[ai][bj][m][0] * rstd, acc[ai][bj][m][1] * rstd); }
    }
};
struct EpiVT { EPI_COMMON bf16_t* O; const float* SSQ;
    DI void operator() EPI_SIG {
        const size_t row0 = (size_t)u.pm * 256 + wr * 64 + fr; const int col0 = u.pn * 256 + wc * 32 + 8 * fq;
        UNROLL for (int bj = 0; bj < 2; ++bj) { f32x4 rs[2];
            UNROLL for (int n = 0; n < 2; ++n) UNROLL for (int j = 0; j < 4; ++j) { const size_t tok = (size_t)col0 + bj * 128 + 4 * n + j;
                const f32x4 sq = *(const f32x4*)(SSQ + tok * 8 + 4); rs[n][j] = rsqrtf((sq[0] + sq[1] + sq[2] + sq[3]) * (1.0f / 256.0f) + RMS_EPS); }
            UNROLL for (int ai = 0; ai < 2; ++ai) UNROLL for (int m = 0; m < 4; ++m) { const size_t row = row0 + ai * 128 + m * 16;
                const size_t col = (size_t)col0 + bj * 128; *(u32x4*)(O + ((col >> 6) * 1024 + row) * 64 + (col & 63)) = pk8(acc[ai][bj][m][0] * rs[0], acc[ai][bj][m][1] * rs[1]); } }
    }
};
struct EpiRes { EPI_COMMON const float* res; float* Y;
    DI void operator() EPI_SIG {
        const size_t row0 = (size_t)u.pm * 256 + wr * 64 + fr; const int col0 = u.pn * 256 + wc * 32 + 8 * fq;
        UNROLL for (int ai = 0; ai < 2; ++ai) UNROLL for (int m = 0; m < 4; ++m) { const size_t row = row0 + ai * 128 + m * 16;
            UNROLL for (int bj = 0; bj < 2; ++bj) UNROLL for (int n = 0; n < 2; ++n) { const size_t idx = row * 1024 + col0 + bj * 128 + 4 * n;
                const f32x4 r = *(const f32x4*)(res + idx); *(f32x4*)(Y + idx) = r * ALPHA + acc[ai][bj][m][n]; } }
    }
};
struct EpiSwiglu { EPI_COMMON bf16_t* H;
    DI void operator() EPI_SIG {
        const size_t row0 = (size_t)u.pm * 256 + wr * 64 + fr; const int col0 = u.pn * 128 + wc * 32 + 8 * fq;
        UNROLL for (int ai = 0; ai < 2; ++ai) UNROLL for (int m = 0; m < 4; ++m) { const size_t row = row0 + ai * 128 + m * 16;
            f32x4 h0, h1;
            UNROLL for (int j = 0; j < 4; ++j) { h0[j] = siluf_(acc[ai][0][m][0][j]) * acc[ai][1][m][0][j]; h1[j] = siluf_(acc[ai][0][m][1][j]) * acc[ai][1][m][1][j]; }
            *(u32x4*)(H + row * DFF + col0) = pk8(h0, h1); }
    }
};
template <bool CHUNKED> struct EpiBf16 { EPI_COMMON bf16_t* O; size_t ldc;
    DI void operator() EPI_SIG {
        const size_t row0 = (size_t)u.pm * 256 + wr * 64 + fr; const int col0 = u.pn * 256 + wc * 32 + 8 * fq;
        UNROLL for (int ai = 0; ai < 2; ++ai) UNROLL for (int m = 0; m < 4; ++m) { const size_t row = row0 + ai * 128 + m * 16;
            UNROLL for (int bj = 0; bj < 2; ++bj) { const size_t col = (size_t)col0 + bj * 128;
                bf16_t* dst = CHUNKED ? O + ((col >> 6) * 1024 + row) * 64 + (col & 63) : O + row * ldc + col;
                *(u32x4*)dst = pk8(acc[ai][bj][m][0], acc[ai][bj][m][1]); } }
    }
};
struct EpiGate { EPI_COMMON const float* XF; const bf16_t* PP; float* OF; bf16_t* OB;
    DI void operator() EPI_SIG {
        const size_t row0 = (size_t)u.pm * 256 + wr * 64 + fr; const int col0 = u.pn * 256 + wc * 32 + 8 * fq;
        UNROLL for (int ai = 0; ai < 2; ++ai) UNROLL for (int m = 0; m < 4; ++m) { const size_t row = row0 + ai * 128 + m * 16;
            UNROLL for (int bj = 0; bj < 2; ++bj) { const size_t idx = row * 1024 + col0 + bj * 128;
                const u32x4 pp = *(const u32x4*)(PP + idx); const f32x4 x0 = *(const f32x4*)(XF + idx), x1 = *(const f32x4*)(XF + idx + 4);
                const f32x4 a0 = acc[ai][bj][m][0], a1 = acc[ai][bj][m][1]; f32x4 o0, o1;
                o0[0] = x0[0] + sigmoidf_(a0[0]) * bflo(pp.x); o0[1] = x0[1] + sigmoidf_(a0[1]) * bfhi(pp.x); o0[2] = x0[2] + sigmoidf_(a0[2]) * bflo(pp.y); o0[3] = x0[3] + sigmoidf_(a0[3]) * bfhi(pp.y);
                o1[0] = x1[0] + sigmoidf_(a1[0]) * bflo(pp.z); o1[1] = x1[1] + sigmoidf_(a1[1]) * bfhi(pp.z); o1[2] = x1[2] + sigmoidf_(a1[2]) * bflo(pp.w); o1[3] = x1[3] + sigmoidf_(a1[3]) * bfhi(pp.w);
                *(f32x4*)(OF + idx) = o0; *(f32x4*)(OF + idx + 4) = o1;
                if (OB) *(u32x4*)(OB + idx) = pk8(o0, o1); } }
    }
};
typedef float f32x2v __attribute__((ext_vector_type(2)));
DI void row_stats(const f32x2v* st, size_t row, int fq, float& mu, float& rstd) {
    const f32x4 a = *(const f32x4*)(st + row * 16 + 4 * fq), b = *(const f32x4*)(st + row * 16 + 4 * fq + 2);
    float s1 = (a[0] + a[2]) + (b[0] + b[2]), s2 = (a[1] + a[3]) + (b[1] + b[3]);
    s1 += __shfl_xor(s1, 16); s1 += __shfl_xor(s1, 32); s2 += __shfl_xor(s2, 16); s2 += __shfl_xor(s2, 32);
    mu = s1 * (1.0f / 1024.0f); const float var = fmaxf(s2 * (1.0f / 1024.0f) - mu * mu, 0.f); rstd = rsqrtf(var + LN_EPS);
}
DI void unpack8(const u32x4& p, f32x4& a, f32x4& b) { a[0] = bflo(p.x); a[1] = bfhi(p.x); a[2] = bflo(p.y); a[3] = bfhi(p.y); b[0] = bflo(p.z); b[1] = bfhi(p.z); b[2] = bflo(p.w); b[3] = bfhi(p.w); }
template <bool LNRES, bool RESBF> struct EpiRes2 { EPI_COMMON const void* res; const f32x2v* stp; const float* g; const float* b; bf16_t* YB; f32x2v* sto;
    DI void operator() EPI_SIG {
        const size_t row0 = (size_t)u.pm * 256 + wr * 64 + fr; const int col0 = u.pn * 256 + wc * 32 + 8 * fq;
        constexpr int MB = RESBF ? 4 : 2;
        UNROLL for (int ai = 0; ai < 2; ++ai) UNROLL for (int mp = 0; mp < 4 / MB; ++mp) {
            float mu[MB], rstd[MB]; u32x4 rb[MB][2]; f32x4 rf[RESBF ? 1 : MB][2][2];
            UNROLL for (int mm = 0; mm < MB; ++mm) { const size_t row = row0 + ai * 128 + (MB * mp + mm) * 16; mu[mm] = 0.f; rstd[mm] = 1.f; if (LNRES) row_stats(stp, row, fq, mu[mm], rstd[mm]);
                UNROLL for (int bj = 0; bj < 2; ++bj) { const size_t idx = row * 1024 + col0 + bj * 128;
                    if (RESBF) rb[mm][bj] = *(const u32x4*)((const bf16_t*)res + idx);
                    else { rf[RESBF ? 0 : mm][bj][0] = *(const f32x4*)((const float*)res + idx); rf[RESBF ? 0 : mm][bj][1] = *(const f32x4*)((const float*)res + idx + 4); } } }
            UNROLL for (int mm = 0; mm < MB; ++mm) { const int m = MB * mp + mm; const size_t row = row0 + ai * 128 + m * 16;
                float s1 = 0.f, s2 = 0.f;
                UNROLL for (int bj = 0; bj < 2; ++bj) { f32x4 yv[2], rr[2];
                    if (RESBF) unpack8(rb[mm][bj], rr[0], rr[1]); else { rr[0] = rf[RESBF ? 0 : mm][bj][0]; rr[1] = rf[RESBF ? 0 : mm][bj][1]; }
                    UNROLL for (int n = 0; n < 2; ++n) { const int col = col0 + bj * 128 + 4 * n;
                        f32x4 r1 = rr[n];
                        if (LNRES) r1 = (r1 - mu[mm]) * rstd[mm] * *(const f32x4*)(g + col) + *(const f32x4*)(b + col);
                        const f32x4 y = r1 * ALPHA + acc[ai][bj][m][n]; yv[n] = y;
                        s1 += (y[0] + y[1]) + (y[2] + y[3]); s2 += (y[0] * y[0] + y[1] * y[1]) + (y[2] * y[2] + y[3] * y[3]); }
                    *(u32x4*)(YB + row * 1024 + col0 + bj * 128) = pk8(yv[0], yv[1]); }
                s1 += __shfl_xor(s1, 16); s1 += __shfl_xor(s1, 32); s2 += __shfl_xor(s2, 16); s2 += __shfl_xor(s2, 32);
                if (fq == 0) { f32x2v o; o[0] = s1; o[1] = s2; sto[row * 16 + u.pn * 4 + wc] = o; } } }
    }
};
struct EpiSwigluLN { EPI_COMMON bf16_t* H; const f32x2v* st; const float* cs; const float* bw;
    DI void operator() EPI_SIG {
        const size_t row0 = (size_t)u.pm * 256 + wr * 64 + fr; const int col0 = u.pn * 128 + wc * 32 + 8 * fq, pc0 = u.pn * 256 + wc * 32 + 8 * fq;
        f32x4 csv[2][2], bwv[2][2];
        UNROLL for (int bj = 0; bj < 2; ++bj) UNROLL for (int n = 0; n < 2; ++n) { csv[bj][n] = *(const f32x4*)(cs + pc0 + bj * 128 + 4 * n); bwv[bj][n] = *(const f32x4*)(bw + pc0 + bj * 128 + 4 * n); }
        float mua[2][4], rsa[2][4];
        UNROLL for (int ai = 0; ai < 2; ++ai) UNROLL for (int m = 0; m < 4; ++m) row_stats(st, row0 + ai * 128 + m * 16, fq, mua[ai][m], rsa[ai][m]);
        UNROLL for (int ai = 0; ai < 2; ++ai) UNROLL for (int m = 0; m < 4; ++m) { const size_t row = row0 + ai * 128 + m * 16;
            const float mu = mua[ai][m], rstd = rsa[ai][m];
            f32x4 h[2];
            UNROLL for (int n = 0; n < 2; ++n) { const f32x4 gp = (acc[ai][0][m][n] - csv[0][n] * mu) * rstd + bwv[0][n], up = (acc[ai][1][m][n] - csv[1][n] * mu) * rstd + bwv[1][n];
                UNROLL for (int j = 0; j < 4; ++j) h[n][j] = siluf_(gp[j]) * up[j]; }
            *(u32x4*)(H + row * DFF + col0) = pk8(h[0], h[1]); }
    }
};
struct EpiGateLN { EPI_COMMON const bf16_t* Y2; const f32x2v* st; const float* g; const float* b; const float* cs; const float* bw; const bf16_t* PP; float* OF; bf16_t* OB;
    DI void operator() EPI_SIG {
        const size_t row0 = (size_t)u.pm * 256 + wr * 64 + fr; const int col0 = u.pn * 256 + wc * 32 + 8 * fq;
        UNROLL for (int ai = 0; ai < 2; ++ai) UNROLL for (int mp = 0; mp < 2; ++mp) {
            float mu[2], rstd[2]; u32x4 yv[2][2], ppv[2][2];
            UNROLL for (int mm = 0; mm < 2; ++mm) { const size_t row = row0 + ai * 128 + (2 * mp + mm) * 16; row_stats(st, row, fq, mu[mm], rstd[mm]);
                UNROLL for (int bj = 0; bj < 2; ++bj) { const size_t idx = row * 1024 + col0 + bj * 128; ppv[mm][bj] = *(const u32x4*)(PP + idx); yv[mm][bj] = *(const u32x4*)(Y2 + idx); } }
            UNROLL for (int mm = 0; mm < 2; ++mm) { const int m = 2 * mp + mm; const size_t row = row0 + ai * 128 + m * 16;
                UNROLL for (int bj = 0; bj < 2; ++bj) { const int col = col0 + bj * 128; const size_t idx = row * 1024 + col;
                    f32x4 ppf[2], yf[2]; unpack8(ppv[mm][bj], ppf[0], ppf[1]); unpack8(yv[mm][bj], yf[0], yf[1]);
                    f32x4 o[2];
                    UNROLL for (int n = 0; n < 2; ++n) { const int c = col + 4 * n;
                        const f32x4 xf = (yf[n] - mu[mm]) * rstd[mm] * *(const f32x4*)(g + c) + *(const f32x4*)(b + c);
                        const f32x4 gp = (acc[ai][bj][m][n] - *(const f32x4*)(cs + c) * mu[mm]) * rstd[mm] + *(const f32x4*)(bw + c);
                        UNROLL for (int j = 0; j < 4; ++j) o[n][j] = xf[j] + sigmoidf_(gp[j]) * ppf[n][j];
                        if (OF) *(f32x4*)(OF + idx + 4 * n) = o[n]; }
                    if (OB) *(u32x4*)(OB + idx) = pk8(o[0], o[1]); } } }
    }
};
struct EpiHin { EPI_COMMON bf16_t* QT; bf16_t* KT; bf16_t* KHT; float* DEC; bf16_t* HG; const float* logits;
    DI void operator() EPI_SIG {
        const size_t row0 = (size_t)u.pm * 256 + wr * 64 + fr;
        if (u.pn >= 8) {
            const int col0 = (u.pn - 8) * 256 + wc * 32 + 8 * fq;
            UNROLL for (int ai = 0; ai < 2; ++ai) UNROLL for (int m = 0; m < 4; ++m) { const size_t row = row0 + ai * 128 + m * 16;
                UNROLL for (int bj = 0; bj < 2; ++bj) { f32x4 s0, s1;
                    UNROLL for (int j = 0; j < 4; ++j) { s0[j] = siluf_(acc[ai][bj][m][0][j]); s1[j] = siluf_(acc[ai][bj][m][1][j]); }
                    *(u32x4*)(HG + row * 1024 + col0 + bj * 128) = pk8(s0, s1); } }
            return;
        }
        const int h = u.pn, d0 = wc * 32 + 8 * fq, lane = fq * 16 + fr;
        f32x4 lb[2];
        UNROLL for (int n = 0; n < 2; ++n) UNROLL for (int j = 0; j < 4; ++j) { const int c = h * 128 + d0 + 4 * n + j; lb[n][j] = __builtin_amdgcn_rcpf(1.0f + __expf(logits[c] - logits[1024 + c])); }
        UNROLL for (int ai = 0; ai < 2; ++ai) UNROLL for (int n = 0; n < 2; ++n) { unsigned wq0[4], wk0[4]; UNROLL for (int jp = 0; jp < 2; ++jp) {
            float Gc[4][2], kk[4][2];
            UNROLL for (int m = 0; m < 4; ++m) UNROLL for (int jj = 0; jj < 2; ++jj) {
                const float l = lb[n][2 * jp + jj], fv = l + (1.0f - l) * sigmoidf_(acc[ai][1][m][n][2 * jp + jj]); Gc[m][jj] = __logf(fv); kk[m][jj] = 1.0f - fv; }
            UNROLL for (int k = 1; k < 16; k <<= 1)
                UNROLL for (int m = 0; m < 4; ++m) UNROLL for (int jj = 0; jj < 2; ++jj) { const float t = __shfl_up(Gc[m][jj], k, 16); if (fr >= k) Gc[m][jj] += t; }
            float off[2] = {0.f, 0.f};
            UNROLL for (int m = 0; m < 4; ++m) UNROLL for (int jj = 0; jj < 2; ++jj) { const float tm = __shfl(Gc[m][jj], (lane & 48) | 15); Gc[m][jj] += off[jj]; off[jj] += tm; }
            const size_t cgi = (size_t)u.pm * 4 + ai * 2 + wr; const int dn = d0 + 4 * n + 2 * jp;
            bf16_t* khp = KHT + ((cgi * 8 + h) * 128 + dn) * 64 + fr;
            const float eoff[2] = {__expf(off[0]), __expf(off[1])};
            UNROLL for (int m = 0; m < 4; ++m) { const size_t row = row0 + ai * 128 + m * 16; float qt[2], kt[2];
                UNROLL for (int jj = 0; jj < 2; ++jj) { const float eng = __expf(-Gc[m][jj]), k = kk[m][jj];
                    qt[jj] = siluf_(acc[ai][0][m][n][2 * jp + jj]) * __builtin_amdgcn_rcpf(eng); kt[jj] = k * eng;
                    khp[(size_t)jj * 64 + 16 * m] = f2bf(kt[jj] * eoff[jj]); }
                if (jp == 0) { wq0[m] = pk2(qt[0], qt[1]); wk0[m] = pk2(kt[0], kt[1]); }
                else { u32x2 wq, wk; wq.x = wq0[m]; wq.y = pk2(qt[0], qt[1]); wk.x = wk0[m]; wk.y = pk2(kt[0], kt[1]);
                    *(u32x2*)(QT + row * 1024 + h * 128 + dn - 2) = wq; *(u32x2*)(KT + row * 1024 + h * 128 + dn - 2) = wk; } }
            if (fr == 0) { f32x2v e0; e0[0] = eoff[0]; e0[1] = eoff[1]; *(f32x2v*)(DEC + cgi * 1024 + h * 128 + dn) = e0; }
        } }
    }
};
enum { MAT_ID = 0, MAT_DQKV, MAT_UQ, MAT_UK, MAT_UV, MAT_HIN, MAT_FIN };
template <int MAT> DI int mapcol(int n) {
    if (MAT == MAT_DQKV) { if (n < 512) return n; if (n >= 576) return -1; const int w = n - 512, g = w >> 3, i8 = w & 7; return 512 + (i8 < 4 ? 4 * g + i8 : 32 + 4 * g + (i8 - 4)); }
    if (MAT == MAT_UQ) { if (n < 1024) return (n >> 7) * 192 + (n & 127); const int w = n - 1024, h = w >> 6, r = w & 63, g = r >> 3, i8 = r & 7; return h * 192 + 128 + (i8 < 4 ? 4 * g + i8 : 32 + 4 * g + (i8 - 4)); }
    if (MAT == MAT_UK) return (n >> 7) * 256 + (n & 127);
    if (MAT == MAT_UV) return (n >> 7) * 256 + 128 + (n & 127);
    if (MAT == MAT_HIN) { if (n < 2048) { const int t = n >> 8, r = n & 255; return r < 128 ? t * 128 + r : 1024 + t * 128 + (r - 128); } if (n < 3072) return n + 1024; return n - 1024; }
    if (MAT == MAT_FIN) { const int t = n >> 8, r = n & 255; return r < 128 ? 128 * t + r : DFF + 128 * t + (r - 128); }
    return n;
}
template <int MAT, bool STATS = false> DI void transpose_mat(const float* W, int K, int Nsrc, int Ndst, bf16_t* WT, const float* kscale, float sc, LAS float* scr, int gw, int NGW, int lane,
                                                             const float* kbias = nullptr, float* PC = nullptr, float* PB = nullptr) {
    const int nblk = Ndst / 32, items = (K / 64) * nblk;
    for (int it = gw; it < items; it += NGW) {
        const int kb = it / nblk, nb = it % nblk, k0 = 64 * kb, n0 = 32 * nb;
        const int src = mapcol<MAT>(n0 + (lane & 31));
        float pc = 0.f, pb = 0.f;
        float wv[32];
#pragma unroll
        for (int i = 0; i < 32; ++i) { const int kk = 2 * i + (lane >> 5); wv[i] = (src >= 0) ? __builtin_nontemporal_load(W + (size_t)(k0 + kk) * Nsrc + src) : 0.f; }
#pragma unroll
        for (int i = 0; i < 32; ++i) { const int kk = 2 * i + (lane >> 5); float v = wv[i] * sc;
            if (src >= 0) { if (STATS) pb += v * kbias[k0 + kk]; if (kscale) v *= kscale[k0 + kk]; if (STATS) pc += v; }
            scr[kk * 33 + (lane & 31)] = v; }
        if (STATS) { pc += __shfl_xor(pc, 32); pb += __shfl_xor(pb, 32); if (lane < 32) { PC[(size_t)kb * Ndst + n0 + lane] = pc; PB[(size_t)kb * Ndst + n0 + lane] = pb; } }
        asm volatile("s_waitcnt lgkmcnt(0)" ::: "memory");
        const int c = lane & 7;
#pragma unroll
        for (int j = 0; j < 4; ++j) { const int n = (lane >> 3) + 8 * j; const LAS float* s = scr + (8 * c) * 33 + n;
            u32x4 o; o.x = pk2(s[0 * 33], s[1 * 33]); o.y = pk2(s[2 * 33], s[3 * 33]); o.z = pk2(s[4 * 33], s[5 * 33]); o.w = pk2(s[6 * 33], s[7 * 33]);
            *(u32x4*)(WT + (size_t)(n0 + n) * K + k0 + 8 * c) = o; }
        asm volatile("s_waitcnt lgkmcnt(0)" ::: "memory");
    }
}
DI void cast_bf16(const float* src, bf16_t* dst, size_t n, size_t gt, size_t NGT) {
    for (size_t i = gt; i < n / 8; i += NGT) { const f32x4 a = *(const f32x4*)(src + 8 * i), b = *(const f32x4*)(src + 8 * i + 4); *(u32x4*)(dst + 8 * i) = pk8(a, b); }
}
DI void ln_pass(const float* Y, const float* g, const float* b, float* XF, bf16_t* XB, int gw, int NGW, int lane) {
    f32x4 gv[4], bv[4];
#pragma unroll
    for (int j = 0; j < 4; ++j) { gv[j] = *(const f32x4*)(g + 4 * lane + 256 * j); bv[j] = *(const f32x4*)(b + 4 * lane + 256 * j); }
    for (int row = gw; row < MTOK; row += NGW) {
        const float* y = Y + (size_t)row * 1024 + 4 * lane; f32x4 v[4]; float s = 0.f;
#pragma unroll
        for (int j = 0; j < 4; ++j) { v[j] = *(const f32x4*)(y + 256 * j); s += (v[j][0] + v[j][1]) + (v[j][2] + v[j][3]); }
        const float mean = wave_sum(s) * (1.0f / 1024.0f); float s2 = 0.f;
#pragma unroll
        for (int j = 0; j < 4; ++j) { v[j] = v[j] - mean; s2 += (v[j][0] * v[j][0] + v[j][1] * v[j][1]) + (v[j][2] * v[j][2] + v[j][3] * v[j][3]); }
        const float rstd = rsqrtf(wave_sum(s2) * (1.0f / 1024.0f) + LN_EPS);
#pragma unroll
        for (int j = 0; j < 4; ++j) { const f32x4 o = v[j] * rstd * gv[j] + bv[j]; const size_t idx = (size_t)row * 1024 + 4 * lane + 256 * j;
            *(f32x4*)(XF + idx) = o; u32x2 w; w.x = pk2(o[0], o[1]); w.y = pk2(o[2], o[3]); *(u32x2*)(XB + idx) = w; }
    }
}
constexpr int AT_KP = 400, AT_VP = 136, AT_VOFF = 64 * AT_KP, AT_BUF = AT_VOFF + 128 * AT_VP;
static_assert(2 * AT_BUF <= 131072, "attention LDS");
DI void attn_phase(ldsp lds, const bf16_t* Q, const bf16_t* KN, const bf16_t* KR, const bf16_t* VT, bf16_t* O, int vcu, int G) {
    int tid_ = threadIdx.x; asm volatile("" : "+v"(tid_));
    const int tid = tid_, wid = __builtin_amdgcn_readfirstlane(tid >> 6), lane = tid & 63, l31 = lane & 31, hh = lane >> 5;
    for (int pr = vcu; pr < 1024; pr += G) {
        const int bh = pr >> 4, jj = pr & 15, b = bh >> 3, h = bh & 7;
        const size_t tok0 = (size_t)b * SEQ;
#pragma unroll 1
        for (int half = 0; half < 2; ++half) {
            const int qb = half == 0 ? 31 - jj : jj;
            const int q0 = qb * 256 + wid * 32;
            bf16x8 qf[12];
            { const bf16_t* qp = Q + (tok0 + q0 + l31) * 1536 + h * 192 + hh * 8;
#pragma unroll
              for (int ks = 0; ks < 12; ++ks) qf[ks] = *(const bf16x8*)(qp + ks * 16); }
            f32x16 o[4];
#pragma unroll
            for (int d = 0; d < 4; ++d)
#pragma unroll
                for (int r = 0; r < 16; ++r) o[d][r] = 0.f;
            float mrun = -1e30f, lrun = 0.f;
            const int ntiles = (qb + 1) * 4;
            u32x4 kreg[3], vreg[2];
            const int srow = tid >> 3, scp = tid & 7;
            const bf16_t* knp = KN + (tok0 + srow) * 1024 + h * 128 + scp * 8;
            const bf16_t* krp = KR + (tok0 + srow) * 64 + scp * 8;
            const bf16_t* vtp = VT + ((tok0 >> 6) * 1024 + h * 128 + srow) * 64 + scp * 8;
            const int kdst = srow * AT_KP + scp * 16, vdst = AT_VOFF + srow * AT_VP + scp * 16;
#define AT_LOAD(t) do { const bf16_t* kn_ = knp + (size_t)(t) * 65536; kreg[0] = *(const u32x4*)(kn_); kreg[1] = *(const u32x4*)(kn_ + 64); kreg[2] = *(const u32x4*)(krp + (size_t)(t) * 4096); \
                        const bf16_t* vt_ = vtp + (size_t)(t) * 65536; vreg[0] = *(const u32x4*)(vt_); vreg[1] = *(const u32x4*)(vt_ + 4096); } while (0)
#define AT_STORE(buf) do { ldsp base_ = lds + (buf) * AT_BUF; *(LAS u32x4*)(base_ + kdst) = kreg[0]; *(LAS u32x4*)(base_ + kdst + 128) = kreg[1]; *(LAS u32x4*)(base_ + kdst + 256) = kreg[2]; \
                           lds_w8x2(base_ + vdst, vreg[0]); lds_w8x2(base_ + vdst + 64 * AT_VP, vreg[1]); } while (0)
            AT_LOAD(0); AT_STORE(0); __syncthreads();
#pragma unroll 1
            for (int t = 0; t < ntiles; ++t) {
                const int buf = t & 1, key0 = t * 64;
                if (t + 1 < ntiles) AT_LOAD(t + 1);
                if (key0 <= q0 + 31) {
                    ldsp Lb = lds + buf * AT_BUF;
                    f32x16 s0, s1;
#pragma unroll
                    for (int r = 0; r < 16; ++r) { s0[r] = 0.f; s1[r] = 0.f; }
                    ldsp kb = Lb + l31 * AT_KP + hh * 16;
                    bf16x8 kf[6];
#pragma unroll
                    for (int i = 0; i < 6; ++i) kf[i] = *(const LAS bf16x8*)(kb + (i & 1) * 32 * AT_KP + (i >> 1) * 32);
#pragma unroll
                    for (int i = 0; i < 24; ++i) { const bf16x8 cur = kf[i % 6];
                        if (i + 6 < 24) kf[i % 6] = *(const LAS bf16x8*)(kb + ((i + 6) & 1) * 32 * AT_KP + ((i + 6) >> 1) * 32);
                        if (i & 1) s1 = MFMA32(cur, qf[i >> 1], s1); else s0 = MFMA32(cur, qf[i >> 1], s0); }
#pragma unroll
                    for (int i = 0; i < 6; ++i) __builtin_amdgcn_sched_group_barrier(0x100, 1, 0);
#pragma unroll
                    for (int i = 0; i < 18; ++i) { __builtin_amdgcn_sched_group_barrier(0x008, 1, 0); __builtin_amdgcn_sched_group_barrier(0x100, 1, 0); }
#pragma unroll
                    for (int i = 0; i < 6; ++i) __builtin_amdgcn_sched_group_barrier(0x008, 1, 0);
                    if (key0 + 63 > q0) {
                        const int qpos = q0 + l31;
#pragma unroll
                        for (int r = 0; r < 16; ++r) { const int key = key0 + crow(r, hh); if (key > qpos) s0[r] = -1e30f; if (key + 32 > qpos) s1[r] = -1e30f; }
                    }
                    float mx = s0[0];
#pragma unroll
                    for (int r = 1; r < 16; ++r) mx = fmaxf(mx, s0[r]);
#pragma unroll
                    for (int r = 0; r < 16; ++r) mx = fmaxf(mx, s1[r]);
                    { auto t_ = __builtin_amdgcn_permlane32_swap(__float_as_uint(mx), __float_as_uint(mx), false, false); mx = fmaxf(__uint_as_float(t_[0]), __uint_as_float(t_[1])); }
                    if (__builtin_amdgcn_ballot_w64(mx - mrun > 8.0f) != 0ull) {
                        const float mn = fmaxf(mrun, mx), al = __builtin_amdgcn_exp2f(mrun - mn); mrun = mn; lrun *= al;
#pragma unroll
                        for (int d = 0; d < 4; ++d)
#pragma unroll
                            for (int r = 0; r < 16; ++r) o[d][r] *= al;
                    }
                    float rs = 0.f;
#pragma unroll
                    for (int r = 0; r < 16; ++r) { s0[r] = __builtin_amdgcn_exp2f(s0[r] - mrun); s1[r] = __builtin_amdgcn_exp2f(s1[r] - mrun); rs += s0[r] + s1[r]; }
                    lrun += rs;
                    bf16x8 pa[2][2];
                    pa[0][0] = pack8(s0, 0); pa[0][1] = pack8(s0, 1); pa[1][0] = pack8(s1, 0); pa[1][1] = pack8(s1, 1);
#pragma unroll
                    for (int kb2 = 0; kb2 < 2; ++kb2)
#pragma unroll
                        for (int s2 = 0; s2 < 2; ++s2)
#pragma unroll
                            for (int d = 0; d < 4; ++d) {
                                const bf16x8 va = lds_8x2(Lb + AT_VOFF + (d * 32 + l31) * AT_VP + (kb2 * 32 + 16 * s2 + 4 * hh) * 2, 16);
                                o[d] = MFMA32(va, pa[kb2][s2], o[d]); }
                }
                if (t + 1 < ntiles) AT_STORE(buf ^ 1);
                __syncthreads();
            }
#undef AT_LOAD
#undef AT_STORE
            lrun += __shfl_xor(lrun, 32);
            const float inv = 1.0f / lrun;
            bf16_t* op = O + (tok0 + q0 + l31) * 1024 + h * 128 + 4 * hh;
#pragma unroll
            for (int d = 0; d < 4; ++d)
#pragma unroll
                for (int g = 0; g < 4; ++g) { u32x2 w; w.x = pk2(o[d][4 * g] * inv, o[d][4 * g + 1] * inv); w.y = pk2(o[d][4 * g + 2] * inv, o[d][4 * g + 3] * inv);
                    *(u32x2*)(op + d * 32 + 8 * g) = w; }
        }
    }
}
DI void hgrn_prep(ldsp lds, const float* LOGF, bf16_t* HQ, bf16_t* HK, bf16_t* KHT, float* DEC, int vcu, int G) {
    int tid_ = threadIdx.x; asm volatile("" : "+v"(tid_));
    const int tid = tid_, tg = tid >> 6, cl = tid & 63;
    LAS float* part = (LAS float*)lds;
    int par = 0;
    float lf[8], nlf[8]; unsigned short qv[8], kv[8], nqv[8], nkv[8];
#define HP_LOAD(it_, L, Q_, K_) do { const int cgi_ = (it_) >> 4, col_ = ((it_) & 15) * 64 + cl; const size_t b_ = ((size_t)cgi_ * 64 + 8 * tg) * 1024 + col_; \
        _Pragma("unroll") for (int tt = 0; tt < 8; ++tt) { L[tt] = LOGF[b_ + (size_t)tt * 1024]; Q_[tt] = HQ[b_ + (size_t)tt * 1024]; K_[tt] = HK[b_ + (size_t)tt * 1024]; } } while (0)
    if (vcu < 16384) HP_LOAD(vcu, lf, qv, kv);
#pragma unroll 1
    for (int it = vcu; it < 16384; it += G) {
        const int cgi = it >> 4, col = (it & 15) * 64 + cl; const size_t base = ((size_t)cgi * 64 + 8 * tg) * 1024 + col;
        const bool has_next = it + G < 16384;
        if (has_next) HP_LOAD(it + G, nlf, nqv, nkv);
#pragma unroll
        for (int tt = 1; tt < 8; ++tt) lf[tt] += lf[tt - 1];
        part[par * 512 + tg * 64 + cl] = lf[7];
        __syncthreads();
        float off = 0.f, gl = 0.f;
#pragma unroll
        for (int g2 = 0; g2 < 8; ++g2) { const float v = part[par * 512 + g2 * 64 + cl]; gl += v; if (g2 < tg) off += v; }
        float khv[8];
#pragma unroll
        for (int tt = 0; tt < 8; ++tt) { const float g = off + lf[tt]; const float q = bf2f(qv[tt]), k = bf2f(kv[tt]); const size_t idx = base + (size_t)tt * 1024;
            HQ[idx] = f2bf(q * __expf(g)); HK[idx] = f2bf(k * __expf(-g)); khv[tt] = k * __expf(gl - g); }
        u32x4 w; w.x = pk2(khv[0], khv[1]); w.y = pk2(khv[2], khv[3]); w.z = pk2(khv[4], khv[5]); w.w = pk2(khv[6], khv[7]);
        *(u32x4*)(KHT + (((size_t)cgi * 8 + (col >> 7)) * 128 + (col & 127)) * 64 + 8 * tg) = w;
        if (tg == 0) DEC[(size_t)cgi * 1024 + col] = __expf(gl);
        par ^= 1;
        if (has_next) {
#pragma unroll
            for (int tt = 0; tt < 8; ++tt) { lf[tt] = nlf[tt]; qv[tt] = nqv[tt]; kv[tt] = nkv[tt]; }
        }
    }
#undef HP_LOAD
}
constexpr int HS_QT = 0, HS_KT = 17408, HS_KHT = 34816, HS_VT = 52224, HS_DEC = 56576, HS_BUF = 57344, HS_QP = 272, HS_P = 136, HS_RED = 2 * HS_BUF;
static_assert(HS_RED + 32768 <= 147456, "scan LDS");
DI void hgrn_scan(ldsp lds, const bf16_t* QT, const bf16_t* KT, const bf16_t* KHT, const bf16_t* HVT, const float* DEC, bf16_t* HO, int vcu, int G) {
    int tid_ = threadIdx.x; asm volatile("" : "+v"(tid_));
    const int tid = tid_, wid = __builtin_amdgcn_readfirstlane(tid >> 6), lane = tid & 63, l31 = lane & 31, hh = lane >> 5;
    for (int it = vcu; it < 256; it += G) {
        const int bh = it >> 2, es = it & 3, b = bh >> 3, h = bh & 7;
        const size_t row00 = (size_t)b * SEQ;
        f32x16 st;
#pragma unroll
        for (int r = 0; r < 16; ++r) st[r] = 0.f;
        u32x4 rqA[2], rkA[2], rhA[2], rvA, rdA;
        const int p0 = tid, p1 = tid + 512;
        const bf16_t* qsrc0 = QT + (row00 + (p0 >> 4)) * 1024 + h * 128 + (p0 & 15) * 8; const bf16_t* qsrc1 = QT + (row00 + (p1 >> 4)) * 1024 + h * 128 + (p1 & 15) * 8;
        const bf16_t* ksrc0 = KT + (row00 + (p0 >> 4)) * 1024 + h * 128 + (p0 & 15) * 8; const bf16_t* ksrc1 = KT + (row00 + (p1 >> 4)) * 1024 + h * 128 + (p1 & 15) * 8;
        const int qd0 = (p0 >> 4) * HS_QP + (p0 & 15) * 16, qd1 = (p1 >> 4) * HS_QP + (p1 & 15) * 16;
        const bf16_t* hsrc0 = KHT + (((size_t)b * 128 * 8 + h) * 128 + (p0 >> 3)) * 64 + (p0 & 7) * 8; const bf16_t* hsrc1 = KHT + (((size_t)b * 128 * 8 + h) * 128 + (p1 >> 3)) * 64 + (p1 & 7) * 8;
        const int hd0 = HS_KHT + (p0 >> 3) * HS_P + (p0 & 7) * 16, hd1 = HS_KHT + (p1 >> 3) * HS_P + (p1 & 7) * 16;
        const int tv = tid & 255;
        const bf16_t* vsrc = HVT + ((row00 >> 6) * 1024 + h * 128 + es * 32 + (tv >> 3)) * 64 + (tv & 7) * 8; const int vd = HS_VT + (tv >> 3) * HS_P + (tv & 7) * 16;
        const int td = tid & 31;
        const float* dsrc = DEC + (size_t)b * 128 * 1024 + h * 128 + td * 4; const int dd = HS_DEC + td * 16;
#define HS_LOAD(c, X) do { rq##X[0] = *(const u32x4*)(qsrc0 + (size_t)(c) * 65536); rq##X[1] = *(const u32x4*)(qsrc1 + (size_t)(c) * 65536); \
        rk##X[0] = *(const u32x4*)(ksrc0 + (size_t)(c) * 65536); rk##X[1] = *(const u32x4*)(ksrc1 + (size_t)(c) * 65536); \
        rh##X[0] = *(const u32x4*)(hsrc0 + (size_t)(c) * 65536); rh##X[1] = *(const u32x4*)(hsrc1 + (size_t)(c) * 65536); \
        if (tid < 256) rv##X = *(const u32x4*)(vsrc + (size_t)(c) * 65536); else if (tid < 288) rd##X = *(const u32x4*)(dsrc + (size_t)(c) * 1024); } while (0)
#define HS_STORE(buf, X) do { ldsp B_ = lds + (buf) * HS_BUF; *(LAS u32x4*)(B_ + HS_QT + qd0) = rq##X[0]; *(LAS u32x4*)(B_ + HS_QT + qd1) = rq##X[1]; \
        *(LAS u32x4*)(B_ + HS_KT + qd0) = rk##X[0]; *(LAS u32x4*)(B_ + HS_KT + qd1) = rk##X[1]; lds_w8x2(B_ + hd0, rh##X[0]); lds_w8x2(B_ + hd1, rh##X[1]); \
        if (tid < 256) lds_w8x2(B_ + vd, rv##X); else if (tid < 288) *(LAS u32x4*)(B_ + dd) = rd##X; } while (0)
        HS_LOAD(0, A); HS_STORE(0, A); __syncthreads();
        const int tb = wid >> 2, db = wid & 3;
        LAS float* red = (LAS float*)(lds + HS_RED);
#pragma unroll 1
        for (int c2 = 0; c2 < 128; c2 += 2) {
            { const int c = c2, buf = 0;
              HS_LOAD(c + 1, A);
            ldsp Lb = lds + buf * HS_BUF;
            ldsp qb_ = Lb + HS_QT + (tb * 32 + l31) * HS_QP + db * 64 + hh * 16; ldsp kb_ = Lb + HS_KT + l31 * HS_QP + db * 64 + hh * 16;
            ldsp qr_ = Lb + HS_QT + (tb * 32 + l31) * HS_QP + 8 * hh + db * 64; ldsp vr_ = Lb + HS_VT + l31 * HS_P + 8 * hh;
            const bf16x8 qv0 = *(const LAS bf16x8*)(qb_), qv1 = *(const LAS bf16x8*)(qb_ + 32), k00 = *(const LAS bf16x8*)(kb_), k01 = *(const LAS bf16x8*)(kb_ + 32);
            const bf16x8 qa0 = lds_8x2(qr_, 16), qa1 = lds_8x2(qr_ + 32, 16), v00 = lds_8x2(vr_, 16), v01 = lds_8x2(vr_ + 32, 16);
            bf16x8 k10 = k00, k11 = k01, v10 = v00, v11 = v01;
            if (tb == 1) { k10 = *(const LAS bf16x8*)(kb_ + 32 * HS_QP); k11 = *(const LAS bf16x8*)(kb_ + 32 * HS_QP + 32); v10 = lds_8x2(vr_ + 64, 16); v11 = lds_8x2(vr_ + 96, 16); }
            __builtin_amdgcn_sched_barrier(0);
            f32x16 a0, o;
#pragma unroll
            for (int r = 0; r < 16; ++r) { a0[r] = 0.f; o[r] = 0.f; }
            a0 = MFMA32(k00, qv0, a0); a0 = MFMA32(k01, qv1, a0);
            o = MFMA32(qa0, pack8(st, 0), o); o = MFMA32(qa1, pack8(st, 1), o);
            { const float z0 = (tb == 0) ? 0.f : 1.f;
#pragma unroll
              for (int r = 0; r < 16; ++r) a0[r] *= (crow(r, hh) <= l31) ? 1.f : z0; }
            o = MFMA32(pack8(a0, 0), v00, o); o = MFMA32(pack8(a0, 1), v01, o);
            if (tb == 1) {
#pragma unroll
                for (int r = 0; r < 16; ++r) a0[r] = 0.f;
                a0 = MFMA32(k10, qv0, a0); a0 = MFMA32(k11, qv1, a0);
#pragma unroll
                for (int r = 0; r < 16; ++r) a0[r] *= (crow(r, hh) <= l31) ? 1.f : 0.f;
                o = MFMA32(pack8(a0, 0), v10, o); o = MFMA32(pack8(a0, 1), v11, o);
            }
            bf16x8 ka[4], vb[4];
#pragma unroll
            for (int ks = 0; ks < 4; ++ks) { ka[ks] = lds_8x2(Lb + HS_KHT + (db * 32 + l31) * HS_P + (ks * 16 + hh * 8) * 2, 8); vb[ks] = lds_8x2(Lb + HS_VT + l31 * HS_P + (ks * 16 + hh * 8) * 2, 8); }
            __builtin_amdgcn_sched_barrier(0);
            __syncthreads();
#pragma unroll
            for (int r = 0; r < 16; ++r) red[wid * 1024 + r * 64 + lane] = o[r];
#pragma unroll
            for (int r = 0; r < 16; ++r) st[r] *= *(const LAS float*)(Lb + HS_DEC + (db * 32 + crow(r, hh)) * 4);
#pragma unroll
            for (int ks = 0; ks < 4; ++ks) st = MFMA32(ka[ks], vb[ks], st);
            HS_STORE(1, A);
            __syncthreads();
            { bf16_t* op = HO + (row00 + (size_t)c * 64 + tb * 32 + 8 * db + 4 * hh) * 1024 + h * 128 + es * 32 + l31;
#pragma unroll
              for (int i = 0; i < 4; ++i) { const int ro = (4 * db + i) * 64 + lane; const float v = (red[(tb * 4 + 0) * 1024 + ro] + red[(tb * 4 + 1) * 1024 + ro]) + (red[(tb * 4 + 2) * 1024 + ro] + red[(tb * 4 + 3) * 1024 + ro]);
                  op[(size_t)i * 1024] = f2bf(v); } }
            }
            { const int c = c2 + 1, buf = 1;
              if (c + 1 < 128) HS_LOAD(c + 1, A);
            ldsp Lb = lds + buf * HS_BUF;
            ldsp qb_ = Lb + HS_QT + (tb * 32 + l31) * HS_QP + db * 64 + hh * 16; ldsp kb_ = Lb + HS_KT + l31 * HS_QP + db * 64 + hh * 16;
            ldsp qr_ = Lb + HS_QT + (tb * 32 + l31) * HS_QP + 8 * hh + db * 64; ldsp vr_ = Lb + HS_VT + l31 * HS_P + 8 * hh;
            const bf16x8 qv0 = *(const LAS bf16x8*)(qb_), qv1 = *(const LAS bf16x8*)(qb_ + 32), k00 = *(const LAS bf16x8*)(kb_), k01 = *(const LAS bf16x8*)(kb_ + 32);
            const bf16x8 qa0 = lds_8x2(qr_, 16), qa1 = lds_8x2(qr_ + 32, 16), v00 = lds_8x2(vr_, 16), v01 = lds_8x2(vr_ + 32, 16);
            bf16x8 k10 = k00, k11 = k01, v10 = v00, v11 = v01;
            if (tb == 1) { k10 = *(const LAS bf16x8*)(kb_ + 32 * HS_QP); k11 = *(const LAS bf16x8*)(kb_ + 32 * HS_QP + 32); v10 = lds_8x2(vr_ + 64, 16); v11 = lds_8x2(vr_ + 96, 16); }
            __builtin_amdgcn_sched_barrier(0);
            f32x16 a0, o;
#pragma unroll
            for (int r = 0; r < 16; ++r) { a0[r] = 0.f; o[r] = 0.f; }
            a0 = MFMA32(k00, qv0, a0); a0 = MFMA32(k01, qv1, a0);
            o = MFMA32(qa0, pack8(st, 0), o); o = MFMA32(qa1, pack8(st, 1), o);
            { const float z0 = (tb == 0) ? 0.f : 1.f;
#pragma unroll
              for (int r = 0; r < 16; ++r) a0[r] *= (crow(r, hh) <= l31) ? 1.f : z0; }
            o = MFMA32(pack8(a0, 0), v00, o); o = MFMA32(pack8(a0, 1), v01, o);
            if (tb == 1) {
#pragma unroll
                for (int r = 0; r < 16; ++r) a0[r] = 0.f;
                a0 = MFMA32(k10, qv0, a0); a0 = MFMA32(k11, qv1, a0);
#pragma unroll
                for (int r = 0; r < 16; ++r) a0[r] *= (crow(r, hh) <= l31) ? 1.f : 0.f;
                o = MFMA32(pack8(a0, 0), v10, o); o = MFMA32(pack8(a0, 1), v11, o);
            }
            bf16x8 ka[4], vb[4];
#pragma unroll
            for (int ks = 0; ks < 4; ++ks) { ka[ks] = lds_8x2(Lb + HS_KHT + (db * 32 + l31) * HS_P + (ks * 16 + hh * 8) * 2, 8); vb[ks] = lds_8x2(Lb + HS_VT + l31 * HS_P + (ks * 16 + hh * 8) * 2, 8); }
            __builtin_amdgcn_sched_barrier(0);
            __syncthreads();
#pragma unroll
            for (int r = 0; r < 16; ++r) red[wid * 1024 + r * 64 + lane] = o[r];
#pragma unroll
            for (int r = 0; r < 16; ++r) st[r] *= *(const LAS float*)(Lb + HS_DEC + (db * 32 + crow(r, hh)) * 4);
#pragma unroll
            for (int ks = 0; ks < 4; ++ks) st = MFMA32(ka[ks], vb[ks], st);
            if (c + 1 < 128) HS_STORE(0, A);
            __syncthreads();
            { bf16_t* op = HO + (row00 + (size_t)c * 64 + tb * 32 + 8 * db + 4 * hh) * 1024 + h * 128 + es * 32 + l31;
#pragma unroll
              for (int i = 0; i < 4; ++i) { const int ro = (4 * db + i) * 64 + lane; const float v = (red[(tb * 4 + 0) * 1024 + ro] + red[(tb * 4 + 1) * 1024 + ro]) + (red[(tb * 4 + 2) * 1024 + ro] + red[(tb * 4 + 3) * 1024 + ro]);
                  op[(size_t)i * 1024] = f2bf(v); } }
            }
        }
#undef HS_LOAD
#undef HS_STORE
    }
}
DI void hgrn_norm(const bf16_t* HO, const bf16_t* HG, const float* gn, bf16_t* HA, int gw, int NGW, int lane) {
    float gv[16];
#pragma unroll
    for (int j = 0; j < 16; ++j) gv[j] = gn[16 * lane + j];
    for (int row = gw; row < MTOK; row += 4 * NGW) {
        u32x4 a[4][2], g[4][2];
#pragma unroll
        for (int k = 0; k < 4; ++k) { const int rr = row + k * NGW; if (rr < MTOK) { const size_t idx = (size_t)rr * 1024 + 16 * lane;
            a[k][0] = *(const u32x4*)(HO + idx); a[k][1] = *(const u32x4*)(HO + idx + 8); g[k][0] = *(const u32x4*)(HG + idx); g[k][1] = *(const u32x4*)(HG + idx + 8); } }
#pragma unroll
        for (int k = 0; k < 4; ++k) { const int rr = row + k * NGW; if (rr < MTOK) { const size_t idx = (size_t)rr * 1024 + 16 * lane;
            f32x4 v[4], gg[4]; unpack8(a[k][0], v[0], v[1]); unpack8(a[k][1], v[2], v[3]); unpack8(g[k][0], gg[0], gg[1]); unpack8(g[k][1], gg[2], gg[3]);
            float ss = 0.f;
#pragma unroll
            for (int q = 0; q < 4; ++q) ss += (v[q][0] * v[q][0] + v[q][1] * v[q][1]) + (v[q][2] * v[q][2] + v[q][3] * v[q][3]);
            ss += __shfl_xor(ss, 1); ss += __shfl_xor(ss, 2); ss += __shfl_xor(ss, 4);
            const float rstd = rsqrtf(ss * (1.0f / 128.0f) + RMS_EPS);
            f32x4 o[4];
#pragma unroll
            for (int q = 0; q < 4; ++q)
#pragma unroll
                for (int j = 0; j < 4; ++j) o[q][j] = v[q][j] * rstd * gv[4 * q + j] * gg[q][j];
            *(u32x4*)(HA + idx) = pk8(o[0], o[1]); *(u32x4*)(HA + idx + 8) = pk8(o[2], o[3]); } }
    }
}
#define XB_TMO      128
#define XB_XCNT(j)  (256  + 64 * (j))
#define XB_XSUB(j)  (1280 + 64 * (j))
#define XB_XGEN(j)  (2304 + 64 * (j))
#define XB_TOP      3328
#define XB_TOPGEN   3392
#define XCD_BAR_WORDS 3456
#define XB_SPIN_CAP (1u << 18)

__device__ __forceinline__ unsigned xb_ld(unsigned* p)              { return __hip_atomic_load(p, __ATOMIC_RELAXED, __HIP_MEMORY_SCOPE_AGENT); }
__device__ __forceinline__ unsigned xb_add(unsigned* p, unsigned v) { return __hip_atomic_fetch_add(p, v, __ATOMIC_RELAXED, __HIP_MEMORY_SCOPE_AGENT); }
__device__ __forceinline__ unsigned xb_xcc_id() { return (unsigned)__builtin_amdgcn_s_getreg((3 << 11) | 20) & 0xFu; }
#define XB_SPIN(cond, bar) do { unsigned _sp = 0; while (cond) { __builtin_amdgcn_s_sleep(1); \
    if ((++_sp & 255u) == 0u) { if (xb_ld(&(bar)[XB_TMO])) break; if (_sp > XB_SPIN_CAP) { atomicAdd(&(bar)[XB_TMO], 1u); break; } } } } while (0)

struct XcdBarrier {
    unsigned* bar; unsigned x;
    volatile LAS unsigned* st;
};

__device__ __forceinline__ XcdBarrier xcd_barrier_post(unsigned* bar, volatile LAS unsigned* st) {
    XcdBarrier b; b.bar = bar; b.x = xb_xcc_id(); b.st = st;
    if (threadIdx.x == 0) (void)xb_add(&bar[XB_XCNT(b.x)], 1u);
    return b;
}
__device__ __forceinline__ void xcd_barrier_complete(unsigned* bar, unsigned x, unsigned& nloc, unsigned& nx) {
    const unsigned G = gridDim.x * gridDim.y * gridDim.z;
    unsigned sum, cnt, mine, sp = 0u;
    for (;;) {
        sum = 0u; cnt = 0u; mine = 0u;
#pragma unroll
        for (unsigned j = 0; j < 16; ++j) { const unsigned c = xb_ld(&bar[XB_XCNT(j)]); sum += c; cnt += (c > 0u) ? 1u : 0u; mine = (j == x) ? c : mine; }
        if (sum == G) break;
        __builtin_amdgcn_s_sleep(1);
        if ((++sp & 255u) == 0u) { if (xb_ld(&bar[XB_TMO])) break; if (sp > XB_SPIN_CAP) { atomicAdd(&bar[XB_TMO], 1u); break; } }
    }
    nloc = mine > 0u ? mine : 1u; nx = cnt > 0u ? cnt : 1u;
}

__device__ __forceinline__ void xcd_barrier(const XcdBarrier& b) {
    asm volatile("s_waitcnt vmcnt(0)" ::: "memory");
    __syncthreads();
    if (threadIdx.x == 0) {
        unsigned* bar = b.bar;
        __builtin_amdgcn_s_waitcnt(0);
        unsigned nloc = b.st[0], nx = b.st[1];
        if (nloc == 0u) { xcd_barrier_complete(bar, b.x, nloc, nx); b.st[0] = nloc; b.st[1] = nx; }
        const unsigned old = xb_add(&bar[XB_XSUB(b.x)], 1u);
        const unsigned gen = old / nloc;
        if (old + 1u == (gen + 1u) * nloc) {
            __builtin_amdgcn_fence(__ATOMIC_RELEASE, "agent");
            asm volatile("s_waitcnt vmcnt(0)" ::: "memory");
            const unsigned og = xb_add(&bar[XB_TOP], 1u);
            const unsigned tg = og / nx;
            if (og + 1u == (tg + 1u) * nx) xb_add(&bar[XB_TOPGEN], 1u);
            else XB_SPIN(xb_ld(&bar[XB_TOPGEN]) == tg, bar);
            __builtin_amdgcn_fence(__ATOMIC_ACQUIRE, "agent");
            xb_add(&bar[XB_XGEN(b.x)], 1u);
            asm volatile("s_waitcnt vmcnt(0)" ::: "memory");
        } else {
            XB_SPIN(xb_ld(&bar[XB_XGEN(b.x)]) == gen, bar);
            __builtin_amdgcn_fence(__ATOMIC_ACQUIRE, "agent");
            asm volatile("s_waitcnt vmcnt(0)" ::: "memory");
        }
    }
    __syncthreads();
}

struct Args { const void* in[21]; float* out; unsigned char* ws; int ph_lo, ph_hi; };
constexpr int N_PHASES = 20;

template <class Epi> DI void run_gemm(ldsp lds, const bf16_t* A, const bf16_t* Bt, int M, int N, int K, const Epi& E) {
    asm volatile("" : "+s"(M), "+s"(N), "+s"(K));
    pg8::Gemm g{A, Bt, M, N, K}; pg8::StaticOrder S; S.init(M, N, (int)gridDim.x, (int)blockIdx.x);
    pg8::gemm_phase<Epi, pg8::StaticOrder, true, true>(lds, g, S, E);
}

__global__ void __launch_bounds__(512, 2) mk_fwd(Args args) {
    extern __shared__ __attribute__((aligned(16))) unsigned char lds_raw[];
    ldsp lds = (ldsp)lds_raw;
    cg::grid_group grid = cg::this_grid();
    const int tid = threadIdx.x, lane = tid & 63, wave = __builtin_amdgcn_readfirstlane(tid >> 6);
    const int G = gridDim.x, bx = blockIdx.x, vcu = (G % 8 == 0) ? (bx % 8) * (G / 8) + bx / 8 : bx;
    const int gw = vcu * 8 + wave, NGW = G * 8;
    const size_t gt = (size_t)bx * 512 + tid, NGT = (size_t)G * 512;
    const int lo = args.ph_lo, hi = args.ph_hi;
    volatile LAS unsigned* xst = (volatile LAS unsigned*)(lds + 147456);
    if (tid < 2) xst[tid] = 0u;
    __syncthreads();
    XcdBarrier xbar; xbar.bar = (unsigned*)(args.ws + 512 * 1024); xbar.x = 0; xbar.st = xst;
    unsigned char* ws = args.ws; unsigned char* dout = (unsigned char*)args.out;
    const float* x_in = (const float*)args.in[0]; const float* p_in = (const float*)args.in[1]; const int* pos = (const int*)args.in[2];
    bf16_t* WB = (bf16_t*)(ws + WS_W);
    bf16_t* PB = (bf16_t*)(ws + WS_PB); bf16_t* XB = (bf16_t*)(ws + WS_XB); float* XF = (float*)(ws + WS_XF); bf16_t* XB2 = (bf16_t*)(ws + WS_XB2);
    float* YW = (float*)(ws + WS_Y); float* YD = (float*)dout; bf16_t* PP = (bf16_t*)(ws + WS_PP); bf16_t* H = (bf16_t*)(ws + WS_H);
    bf16_t* Qb = (bf16_t*)(ws + WS_Q); bf16_t* DQ = (bf16_t*)(ws + WS_DQ); bf16_t* DKV = (bf16_t*)(ws + WS_DKV); bf16_t* KN = (bf16_t*)(ws + WS_KN); bf16_t* VT = (bf16_t*)(ws + WS_VT);
    bf16_t* Ob = (bf16_t*)(dout + DO_O); bf16_t* KR = (bf16_t*)(dout + DO_KR); float* SSQ = (float*)(dout + DO_SSQ);
    bf16_t* HQ = (bf16_t*)(ws + WS_HQ); float* LOGF = (float*)(ws + WS_LOGF); bf16_t* HK = (bf16_t*)(ws + WS_HK); bf16_t* HVT = (bf16_t*)(dout + DO_HVT); bf16_t* HG = (bf16_t*)(dout + DO_HG);
    bf16_t* KHT = (bf16_t*)(ws + WS_KHT); float* DEC = (float*)(ws + WS_DEC); bf16_t* HO = (bf16_t*)(ws + WS_HO); bf16_t* HA = (bf16_t*)(dout + DO_HA);
    f32x2v* ST1 = (f32x2v*)(ws + WS_ST1); f32x2v* ST2 = (f32x2v*)(ws + WS_ST2); float* CTLF = (float*)ws; float* PART = (float*)(ws + WS_PART);
    const float* lnmg = (const float*)args.in[15]; const float* lnmb = (const float*)args.in[16]; const float* lnfg = (const float*)args.in[17]; const float* lnfb = (const float*)args.in[18];
#ifndef SKIPMASK
#define SKIPMASK 0u
#endif
#define RUN(k) (lo <= (k) && (k) < hi && !((SKIPMASK >> (k)) & 1u))
#ifndef REPEATMASK
#define REPEATMASK 0u
#endif
#define REP(k) for (int rep_ = 0; rep_ < 1 + (int)((REPEATMASK >> (k)) & 1u); ++rep_)
#define RSYNC() do { if (rep_) grid.sync(); } while (0)
#define SEAM(k) do { if (RUN(k) && RUN((k) + 1)) { if ((k) == 0) grid.sync(); else xcd_barrier(xbar); } } while (0)

    if (RUN(0)) REP(0) { RSYNC();
        LAS float* scr = (LAS float*)(lds + wave * 16384);
        transpose_mat<MAT_DQKV>((const float*)args.in[3], 1024, 576, 768, WB + W_DQKV, nullptr, 1.f, scr, gw, NGW, lane);
        transpose_mat<MAT_UQ>((const float*)args.in[6], 256, 1536, 1536, WB + W_UQ, (const float*)args.in[4], QSCALE, scr, gw, NGW, lane);
        transpose_mat<MAT_UK>((const float*)args.in[7], 256, 2048, 1024, WB + W_UK, (const float*)args.in[5], 1.f, scr, gw, NGW, lane);
        transpose_mat<MAT_UV>((const float*)args.in[7], 256, 2048, 1024, WB + W_UV, (const float*)args.in[5], 1.f, scr, gw, NGW, lane);
        transpose_mat<MAT_ID>((const float*)args.in[8], 1024, 1024, 1024, WB + W_WO, nullptr, 1.f, scr, gw, NGW, lane);
        transpose_mat<MAT_HIN>((const float*)args.in[9], 1024, 4096, 4096, WB + W_HIN, nullptr, 1.f, scr, gw, NGW, lane);
        transpose_mat<MAT_ID>((const float*)args.in[12], 1024, 1024, 1024, WB + W_HO, nullptr, 1.f, scr, gw, NGW, lane);
        for (int i = 0; i < 2; ++i) {
            transpose_mat<MAT_FIN, true>((const float*)args.in[13] + (size_t)i * 1024 * 5632, 1024, 5632, 5632, WB + W_FIN + (size_t)i * 5632 * 1024, lnmg + i * 1024, 1.f, scr, gw, NGW, lane,
                                         lnmb + i * 1024, PART + P_FIN + (size_t)(i * 2 + 0) * 16 * 5632, PART + P_FIN + (size_t)(i * 2 + 1) * 16 * 5632);
            transpose_mat<MAT_ID>((const float*)args.in[14] + (size_t)i * 2816 * 1024, 2816, 1024, 1024, WB + W_FDN + (size_t)i * 1024 * 2816, nullptr, 1.f, scr, gw, NGW, lane);
            transpose_mat<MAT_ID>((const float*)args.in[19] + (size_t)i * 256 * 1024, 256, 1024, 1024, WB + W_PPJ + (size_t)i * 1024 * 256, nullptr, 1.f, scr, gw, NGW, lane);
            transpose_mat<MAT_ID, true>((const float*)args.in[20] + (size_t)i * 1024 * 1024, 1024, 1024, 1024, WB + W_PG + (size_t)i * 1024 * 1024, lnfg + i * 1024, 1.f, scr, gw, NGW, lane,
                                        lnfb + i * 1024, PART + P_PG + (size_t)(i * 2 + 0) * 16 * 1024, PART + P_PG + (size_t)(i * 2 + 1) * 16 * 1024);
        }
        cast_bf16(x_in, XB, (size_t)MTOK * 1024, gt, NGT);
        cast_bf16(p_in, PB, (size_t)2 * MTOK * 256, gt, NGT);
    }
    if (RUN(0) && bx == 0) { unsigned* bw = (unsigned*)(args.ws + 512 * 1024); for (int i = tid; i < 4096; i += 512) bw[i] = 0u; }
    SEAM(0);
    xbar = xcd_barrier_post((unsigned*)(args.ws + 512 * 1024), xst);
    if (RUN(1)) REP(1) { RSYNC();
        if (gt < 2 * (5632 + 1024)) {
            const int i = (int)gt; float c = 0.f, bsum = 0.f;
            if (i < 2 * 5632) { const int ly = i / 5632, n = i % 5632; const float* pc = PART + P_FIN + (size_t)(ly * 2) * 16 * 5632 + n; const float* pb = pc + 16 * 5632;
                for (int kb = 0; kb < 16; ++kb) { c += pc[kb * 5632]; bsum += pb[kb * 5632]; }
                CTLF[C_CSF + ly * 5632 + n] = c; CTLF[C_BWF + ly * 5632 + n] = bsum;
            } else { const int i2 = i - 2 * 5632, ly = i2 / 1024, n = i2 % 1024; const float* pc = PART + P_PG + (size_t)(ly * 2) * 16 * 1024 + n; const float* pb = pc + 16 * 1024;
                for (int kb = 0; kb < 16; ++kb) { c += pc[kb * 1024]; bsum += pb[kb * 1024]; }
                CTLF[C_CSG + ly * 1024 + n] = c; CTLF[C_BWG + ly * 1024 + n] = bsum; }
        }
        EpiDown E{DQ, DKV, KR, SSQ, pos}; run_gemm(lds, XB, WB + W_DQKV, MTOK, 768, 1024, E); }
    SEAM(1);
    if (RUN(2)) REP(2) { RSYNC();
#ifndef NO_P2A
        { EpiUQ E{Qb, SSQ, pos}; run_gemm(lds, DQ, WB + W_UQ, MTOK, 1536, 256, E); }
#endif
#ifndef NO_P2B
        { EpiUK E{KN, SSQ}; run_gemm(lds, DKV, WB + W_UK, MTOK, 1024, 256, E); }
#endif
#ifndef NO_P2C
        { EpiVT E{VT, SSQ}; run_gemm(lds, WB + W_UV, DKV, 1024, MTOK, 256, E); }
#endif
    }
    SEAM(2);
    if (RUN(3)) REP(3) { RSYNC(); attn_phase(lds, Qb, KN, KR, VT, Ob, vcu, G); }
    SEAM(3);
    if (RUN(4)) REP(4) { RSYNC(); EpiRes2<false, false> E{x_in, nullptr, nullptr, nullptr, XB, ST1}; run_gemm(lds, Ob, WB + W_WO, MTOK, 1024, 1024, E); }
    SEAM(4);
    if (RUN(6)) REP(6) { RSYNC();
        { EpiSwigluLN E{H, ST1, CTLF + C_CSF, CTLF + C_BWF}; run_gemm(lds, XB, WB + W_FIN, MTOK, 5632, 1024, E); }
        { EpiBf16<false> E{PP, 1024}; run_gemm(lds, PB, WB + W_PPJ, MTOK, 1024, 256, E); }
    }
    SEAM(6);
    if (RUN(7)) REP(7) { RSYNC(); EpiRes2<true, true> E{XB, ST1, lnmg, lnmb, XB, ST2}; run_gemm(lds, H, WB + W_FDN, MTOK, 1024, 2816, E); }
    SEAM(7);
    if (RUN(9)) REP(9) { RSYNC(); EpiGateLN E{XB, ST2, lnfg, lnfb, CTLF + C_CSG, CTLF + C_BWG, PP, nullptr, XB2}; run_gemm(lds, XB, WB + W_PG, MTOK, 1024, 1024, E); }
    SEAM(9);
    if (RUN(10)) REP(10) { RSYNC();
        { EpiHin E{HQ, HK, KHT, DEC, HG, (const float*)args.in[10]}; run_gemm(lds, XB2, WB + W_HIN, MTOK, 3072, 1024, E); }
        { EpiBf16<true> E{HVT, 65536}; run_gemm(lds, WB + W_HIN + (size_t)3072 * 1024, XB2, 1024, MTOK, 1024, E); }
    }
    SEAM(10);
    if (RUN(12)) REP(12) { RSYNC(); hgrn_scan(lds, HQ, HK, KHT, HVT, DEC, HO, vcu, G); }
    SEAM(12);
    if (RUN(13)) REP(13) { RSYNC(); hgrn_norm(HO, HG, (const float*)args.in[11], HA, gw, NGW, lane); }
    SEAM(13);
    if (RUN(14)) REP(14) { RSYNC(); EpiRes2<false, true> E{XB2, nullptr, nullptr, nullptr, XB, ST1}; run_gemm(lds, HA, WB + W_HO, MTOK, 1024, 1024, E); }
    SEAM(14);
    if (RUN(16)) REP(16) { RSYNC();
        { EpiSwigluLN E{H, ST1, CTLF + C_CSF + 5632, CTLF + C_BWF + 5632}; run_gemm(lds, XB, WB + W_FIN + (size_t)5632 * 1024, MTOK, 5632, 1024, E); }
        { EpiBf16<false> E{PP, 1024}; run_gemm(lds, PB + (size_t)MTOK * 256, WB + W_PPJ + (size_t)1024 * 256, MTOK, 1024, 256, E); }
    }
    SEAM(16);
    if (RUN(17)) REP(17) { RSYNC(); EpiRes2<true, true> E{XB, ST1, lnmg + 1024, lnmb + 1024, XB, ST2}; run_gemm(lds, H, WB + W_FDN + (size_t)1024 * 2816, MTOK, 1024, 2816, E); }
    SEAM(17);
    if (RUN(19)) REP(19) { RSYNC(); EpiGateLN E{XB, ST2, lnfg + 1024, lnfb + 1024, CTLF + C_CSG + 1024, CTLF + C_BWG + 1024, PP, YD, nullptr}; run_gemm(lds, XB, WB + W_PG + (size_t)1024 * 1024, MTOK, 1024, 1024, E); }
#undef RUN
#undef SEAM
}

#ifndef MK_MULTI
#define MK_MULTI 0
#endif
extern "C" void kernel_launch(void* const* d_in, const int* in_sizes, int n_in, void* d_out, int out_size, void* d_ws, size_t ws_size, hipStream_t stream) {
    static int grid = 0;
    if (grid == 0) {
        int dev = 0, cus = 0, per_cu = 0;
        hipGetDevice(&dev);
        hipDeviceGetAttribute(&cus, hipDeviceAttributeMultiprocessorCount, dev);
        hipFuncSetAttribute((const void*)mk_fwd, hipFuncAttributeMaxDynamicSharedMemorySize, LDS_BYTES);
        hipOccupancyMaxActiveBlocksPerMultiprocessor(&per_cu, (const void*)mk_fwd, 512, LDS_BYTES);
        if (per_cu < 1) { fprintf(stderr, "kernel_launch: occupancy query says %d blocks per CU\n", per_cu); per_cu = 1; }
        (void)hipGetLastError();
        grid = cus * 1;
        if (n_in != 21 || ws_size < 1024 * MiB) fprintf(stderr, "kernel_launch: unexpected n_in %d / ws_size %zu\n", n_in, ws_size);
    }
    Args a{};
    for (int i = 0; i < 21; ++i) a.in[i] = d_in[i];
    a.out = (float*)d_out; a.ws = (unsigned char*)d_ws;
#if MK_MULTI
    for (int k = 0; k < N_PHASES; ++k) { a.ph_lo = k; a.ph_hi = k + 1; hipLaunchKernelGGL(mk_fwd, dim3(grid), dim3(512), LDS_BYTES, stream, a); }
#else
    a.ph_lo = 0; a.ph_hi = N_PHASES;
    void* kargs[] = {&a};
    hipError_t e = hipLaunchCooperativeKernel((const void*)mk_fwd, dim3(grid), dim3(512), kargs, LDS_BYTES, stream);
    if (e != hipSuccess) fprintf(stderr, "kernel_launch: cooperative launch failed: %s (grid %d)\n", hipGetErrorString(e), grid);
#endif
}
```

```cpp
#include <hip/hip_runtime.h>
#include <hip/hip_cooperative_groups.h>
#include <cstdio>
#include <cstdint>
namespace cg = cooperative_groups;

namespace pg8 {
#define PG8_LAS __attribute__((address_space(3)))
typedef unsigned short bf16_t;
typedef short bf16x8 __attribute__((ext_vector_type(8)));
typedef float f32x4 __attribute__((ext_vector_type(4)));
typedef unsigned u32x4 __attribute__((ext_vector_type(4)));
constexpr int BM = 256, BK = 64, HALF = 128, HTB = HALF * BK * 2  , STAGE_BYTES = 8 * HTB, NXCD = 8, WGM = 8;

__host__ __device__ __forceinline__ int lds_byte(int r, int c) { const int st = (r >> 4) * 2 + (c >> 5), rr = r & 15, cc = c & 31, ob = rr * 64 + cc * 2; return st * 1024 + (ob ^ (((ob >> 9) & 1) << 5)); }
__host__ __device__ __forceinline__ void stage_rc(int b, int& R, int& C) { const int st = b / 1024, sb = b % 1024, swz = sb ^ (((sb >> 9) & 1) << 5); R = (st >> 1) * 16 + swz / 64; C = (st & 1) * 32 + (swz % 64) / 2; }
__host__ __device__ __forceinline__ int perm32(int rho) { const int n = rho >> 4, i = rho & 15; return 8 * (i >> 2) + 4 * n + (i & 3); }

struct Unit { int pm, pn; };
struct Gemm { const bf16_t* A; const bf16_t* Bt; int M, N, K; };

struct StaticOrder {
    int nM, nN, nwg, G, c;
    __host__ __device__ void init(int M, int N, int G_, int c_) { nM = M / BM; nN = N / BM; nwg = nM * nN; G = G_; c = c_; }
    __host__ __device__ bool next(int i, Unit& u) const {
        const long L = (long)i * G + c; if (L >= nwg) return false;
        int wgid = (int)L; { const int q = nwg / NXCD, r = nwg % NXCD, xcd = wgid % NXCD, off = wgid / NXCD; wgid = (xcd < r ? xcd * (q + 1) : r * (q + 1) + (xcd - r) * q) + off; }
        const int nig = WGM * nN, gid = wgid / nig, fm = gid * WGM, gsz = (nM - fm) < WGM ? (nM - fm) : WGM;
        u.pm = fm + ((wgid % nig) % gsz); u.pn = (wgid % nig) / gsz; return true;
    }
    __device__ __forceinline__ void a_ready(const Unit&) const {}
    __device__ __forceinline__ void done(const Unit&) const {}
};

template <class Epi, class Sched, bool ALIGN_EPI = false, bool SP2 = false>
__device__ __forceinline__ void gemm_phase(PG8_LAS unsigned char* lds, const Gemm g, const Sched& S, const Epi& E) {
    int tid_ = threadIdx.x; asm volatile("" : "+v"(tid_));
    const int tid = tid_, wid = __builtin_amdgcn_readfirstlane(tid >> 6), lane = tid & 63, wr = wid >> 2, wc = wid & 3, fr = lane & 15, fq = lane >> 4;
    const int K = g.K, nt = K / BK;
    unsigned voffA[2], voffB[2];
#pragma unroll
    for (int i = 0; i < 2; ++i) { int R, C; stage_rc(tid * 16 + i * 8192, R, C); const int Rb = Epi::PERM ? ((R & ~31) + perm32(R & 31)) : R;
        voffA[i] = (unsigned)(R * K + C) * 2u; voffB[i] = (unsigned)(Rb * K + C) * 2u; }
    const size_t kstep = (size_t)(BK * 2);
    const size_t hstep = (size_t)HALF * K * 2;
    const size_t tstep = 2 * hstep;
    const unsigned ldsw = (unsigned)wid * 1024u;
    const int aoff = lds_byte(wr * 64 + fr, fq * 8), boff = lds_byte(wc * 32 + fr, fq * 8);
#define PG8_SA(b, h) (((b) * 2 + (h)) * HTB)
#define PG8_SB(b, h) ((4 + (b) * 2 + (h)) * HTB)
#define PG8_STAGE(bufoff, gbase, voff) do { _Pragma("unroll") for (int _i = 0; _i < 2; ++_i) \
        __builtin_amdgcn_global_load_lds((const unsigned*)((const char*)(gbase) + (voff)[_i]), (PG8_LAS unsigned*)(lds + (bufoff) + ldsw + _i * 8192), 16, 0, 0); } while (0)
#define PG8_LDA(dst, b, h) do { _Pragma("unroll") for (int m = 0; m < 4; ++m) _Pragma("unroll") for (int k = 0; k < 2; ++k) dst[m][k] = *(const PG8_LAS bf16x8*)(lds + PG8_SA(b, h) + aoff + m * 2048 + k * 1024); } while (0)
#define PG8_LDB(dst, b, h) do { _Pragma("unroll") for (int n = 0; n < 2; ++n) _Pragma("unroll") for (int k = 0; k < 2; ++k) dst[n][k] = *(const PG8_LAS bf16x8*)(lds + PG8_SB(b, h) + boff + n * 2048 + k * 1024); } while (0)
#define PG8_MMA(ai, bj, At, Bt) do { __builtin_amdgcn_s_setprio(1); _Pragma("unroll") for (int m = 0; m < 4; ++m) _Pragma("unroll") for (int n = 0; n < 2; ++n) _Pragma("unroll") for (int k = 0; k < 2; ++k) \
        acc[ai][bj][m][n] = __builtin_amdgcn_mfma_f32_16x16x32_bf16(Bt[n][k], At[m][k], acc[ai][bj][m][n], 0, 0, 0); __builtin_amdgcn_s_setprio(0); } while (0)
#define PG8_WAIT_V(n) asm volatile("s_waitcnt vmcnt(" #n ")" ::: "memory")
#define PG8_WAIT_L(n) asm volatile("s_waitcnt lgkmcnt(" #n ")" ::: "memory")
#define PG8_BAR __builtin_amdgcn_s_barrier()
#define PG8_SCHED __builtin_amdgcn_sched_barrier(0)
    Unit cur, nxt; int ui = 0;
    if (!S.next(0, cur)) return;
    f32x4 acc[2][2][4][2];
#pragma unroll
    for (int a = 0; a < 2; ++a)
#pragma unroll
        for (int b = 0; b < 2; ++b)
#pragma unroll
            for (int m = 0; m < 4; ++m)
#pragma unroll
                for (int n = 0; n < 2; ++n) acc[a][b][m][n] = (f32x4){0.f, 0.f, 0.f, 0.f};
    bf16x8 At[4][2], B0[2][2], B1[2][2];
    const char* cA = (const char*)g.A + (size_t)cur.pm * tstep; const char* cB = (const char*)g.Bt + (size_t)cur.pn * tstep;
    S.a_ready(cur);
    if constexpr (SP2) {
        PG8_STAGE(PG8_SB(0, 0), cB, voffB); PG8_STAGE(PG8_SB(0, 1), cB + hstep, voffB); PG8_STAGE(PG8_SA(0, 0), cA, voffA); PG8_STAGE(PG8_SA(0, 1), cA + hstep, voffA);
        if (wr == 1) PG8_BAR;
        PG8_WAIT_V(2); PG8_BAR;
        PG8_STAGE(PG8_SB(1, 0), cB + kstep, voffB); PG8_STAGE(PG8_SA(1, 0), cA + kstep, voffA); PG8_STAGE(PG8_SB(1, 1), cB + hstep + kstep, voffB);
        PG8_WAIT_V(6); PG8_BAR;
    } else {
        PG8_STAGE(PG8_SB(0, 0), cB, voffB); PG8_STAGE(PG8_SA(0, 0), cA, voffA); PG8_STAGE(PG8_SB(0, 1), cB + hstep, voffB); PG8_STAGE(PG8_SA(0, 1), cA + hstep, voffA);
        if (wr == 1) PG8_BAR;
        PG8_WAIT_V(4); PG8_BAR;
        PG8_STAGE(PG8_SB(1, 0), cB + kstep, voffB); PG8_STAGE(PG8_SA(1, 0), cA + kstep, voffA); PG8_STAGE(PG8_SB(1, 1), cB + hstep + kstep, voffB);
        PG8_WAIT_V(6); PG8_BAR;
    }
    for (;;) {
        const bool has_next = S.next(ui + 1, nxt);
        const char* nA = has_next ? (const char*)g.A + (size_t)nxt.pm * tstep : cA; const char* nB = has_next ? (const char*)g.Bt + (size_t)nxt.pn * tstep : cB;
        for (int t = 0; t < nt; t += 2) {
            const bool last = (t == nt - 2);
            const char* a1 = cA + (size_t)(t + 1) * kstep;
            const char* a2 = last ? nA : cA + (size_t)(t + 2) * kstep; const char* b2 = last ? nB : cB + (size_t)(t + 2) * kstep;
            const char* a3 = a2 + kstep; const char* b3 = b2 + kstep;
            if (last && has_next) S.a_ready(nxt);
            if constexpr (SP2) {
            PG8_LDB(B0, 0, 0); PG8_LDB(B1, 0, 1); PG8_SCHED; PG8_LDA(At, 0, 0); PG8_STAGE(PG8_SA(1, 1), a1 + hstep, voffA);
            PG8_WAIT_V(8); PG8_WAIT_L(0); PG8_BAR; PG8_MMA(0, 0, At, B0); PG8_MMA(0, 1, At, B1); PG8_BAR; PG8_SCHED;
            PG8_LDA(At, 0, 1); PG8_STAGE(PG8_SB(0, 0), b2, voffB); PG8_STAGE(PG8_SB(0, 1), b2 + hstep, voffB); PG8_STAGE(PG8_SA(0, 0), a2, voffA);
            PG8_WAIT_V(8); PG8_WAIT_L(0); PG8_BAR; PG8_MMA(1, 0, At, B0); PG8_MMA(1, 1, At, B1); PG8_BAR; PG8_SCHED;
            PG8_LDB(B0, 1, 0); PG8_LDB(B1, 1, 1); PG8_SCHED; PG8_LDA(At, 1, 0); PG8_STAGE(PG8_SA(0, 1), a2 + hstep, voffA);
            PG8_WAIT_V(8); PG8_WAIT_L(0); PG8_BAR; PG8_MMA(0, 0, At, B0); PG8_MMA(0, 1, At, B1); PG8_BAR; PG8_SCHED;
            PG8_LDA(At, 1, 1); PG8_STAGE(PG8_SB(1, 0), b3, voffB); PG8_STAGE(PG8_SB(1, 1), b3 + hstep, voffB); PG8_STAGE(PG8_SA(1, 0), a3, voffA);
            PG8_WAIT_V(8); PG8_WAIT_L(0); PG8_BAR; PG8_MMA(1, 0, At, B0); PG8_MMA(1, 1, At, B1); PG8_BAR; PG8_SCHED;
            } else {
            PG8_LDB(B0, 0, 0); PG8_SCHED; PG8_LDA(At, 0, 0); PG8_STAGE(PG8_SA(1, 1), a1 + hstep, voffA);
            PG8_WAIT_L(8); PG8_BAR; PG8_WAIT_L(0); PG8_MMA(0, 0, At, B0); PG8_BAR; PG8_SCHED;
            PG8_LDB(B1, 0, 1); PG8_STAGE(PG8_SB(0, 0), b2, voffB);
            PG8_BAR; PG8_WAIT_L(0); PG8_MMA(0, 1, At, B1); PG8_BAR;
            PG8_LDA(At, 0, 1); PG8_STAGE(PG8_SA(0, 0), a2, voffA);
            PG8_BAR; PG8_WAIT_L(0); PG8_MMA(1, 0, At, B0); PG8_BAR; PG8_SCHED;
            PG8_STAGE(PG8_SB(0, 1), b2 + hstep, voffB);
            PG8_WAIT_V(6); PG8_BAR; PG8_MMA(1, 1, At, B1); PG8_BAR;
            PG8_LDB(B0, 1, 0); PG8_SCHED; PG8_LDA(At, 1, 0); PG8_STAGE(PG8_SA(0, 1), a2 + hstep, voffA);
            PG8_WAIT_L(8); PG8_BAR; PG8_WAIT_L(0); PG8_MMA(0, 0, At, B0); PG8_BAR; PG8_SCHED;
            PG8_LDB(B1, 1, 1); PG8_STAGE(PG8_SB(1, 0), b3, voffB);
            PG8_BAR; PG8_WAIT_L(0); PG8_MMA(0, 1, At, B1); PG8_BAR;
            PG8_LDA(At, 1, 1); PG8_STAGE(PG8_SA(1, 0), a3, voffA);
            PG8_BAR; PG8_WAIT_L(0); PG8_MMA(1, 0, At, B0); PG8_BAR; PG8_SCHED;
            PG8_STAGE(PG8_SB(1, 1), b3 + hstep, voffB);
            PG8_WAIT_V(6); PG8_BAR; PG8_MMA(1, 1, At, B1); PG8_BAR;
            }
        }
        if constexpr (ALIGN_EPI) { if (wr == 0) PG8_BAR; }
        if constexpr (!Epi::AFTER_DRAIN) { E(acc, cur, wr, wc, fr, fq); S.done(cur); }
        if (!has_next) break;
#pragma unroll
        for (int a = 0; a < 2; ++a)
#pragma unroll
            for (int b = 0; b < 2; ++b)
#pragma unroll
                for (int m = 0; m < 4; ++m)
#pragma unroll
                    for (int n = 0; n < 2; ++n) acc[a][b][m][n] = (f32x4){0.f, 0.f, 0.f, 0.f};
        cur = nxt; cA = nA; cB = nB; ++ui;
        if constexpr (ALIGN_EPI) { if (wr == 1) PG8_BAR; }
    }
    PG8_WAIT_V(0);
    if constexpr (!ALIGN_EPI) { if (wr == 0) PG8_BAR; }
    PG8_BAR;
    if constexpr (Epi::AFTER_DRAIN) { E.fused(acc, cur, wr, wc, fr, fq, lds, wid, lane); S.done(cur); }
#undef PG8_SA
#undef PG8_SB
#undef PG8_STAGE
#undef PG8_LDA
#undef PG8_LDB
#undef PG8_MMA
#undef PG8_WAIT_V
#undef PG8_WAIT_L
#undef PG8_BAR
#undef PG8_SCHED
}
}
#define LAS __attribute__((address_space(3)))
typedef unsigned short bf16_t;
typedef short bf16x8 __attribute__((ext_vector_type(8)));
typedef short s16x4 __attribute__((ext_vector_type(4)));
typedef float f32x4 __attribute__((ext_vector_type(4)));
typedef float f32x16 __attribute__((ext_vector_type(16)));
typedef unsigned u32x4 __attribute__((ext_vector_type(4)));
typedef unsigned u32x2 __attribute__((ext_vector_type(2)));
typedef __bf16 bf16x2_t __attribute__((ext_vector_type(2)));
typedef float f32x2_t __attribute__((ext_vector_type(2)));
typedef LAS unsigned char* ldsp;

#define DI __device__ __forceinline__
DI unsigned pk2(float lo, float hi) { f32x2_t v = {lo, hi}; bf16x2_t b = __builtin_convertvector(v, bf16x2_t); return __builtin_bit_cast(unsigned, b); }
DI float bflo(unsigned u) { return __builtin_bit_cast(float, u << 16); }
DI float bfhi(unsigned u) { return __builtin_bit_cast(float, u & 0xffff0000u); }
DI float bf2f(bf16_t u) { return __builtin_bit_cast(float, (unsigned)u << 16); }
DI bf16_t f2bf(float f) { return (bf16_t)(pk2(f, 0.f) & 0xffffu); }
DI float sigmoidf_(float x) { return __builtin_amdgcn_rcpf(1.0f + __expf(-x)); }
DI float siluf_(float x) { return x * __builtin_amdgcn_rcpf(1.0f + __expf(-x)); }
DI int crow(int reg, int hh) { return (reg & 3) + 8 * (reg >> 2) + 4 * hh; }
#define MFMA32(a, b, c) __builtin_amdgcn_mfma_f32_32x32x16_bf16((a), (b), (c), 0, 0, 0)
DI bf16x8 pack8(const f32x16& x, int s) {
    u32x4 p; p.x = pk2(x[8 * s + 0], x[8 * s + 1]); p.y = pk2(x[8 * s + 2], x[8 * s + 3]); p.z = pk2(x[8 * s + 4], x[8 * s + 5]); p.w = pk2(x[8 * s + 6], x[8 * s + 7]);
    return __builtin_bit_cast(bf16x8, p);
}
DI bf16x8 lds_8x2(ldsp p, int gap) {
    s16x4 lo = *(const LAS s16x4*)p, hi = *(const LAS s16x4*)(p + gap);
    return __builtin_shufflevector(lo, hi, 0, 1, 2, 3, 4, 5, 6, 7);
}
DI void lds_w8x2(ldsp p, u32x4 v) { u32x2 a = {v.x, v.y}, b = {v.z, v.w}; *(LAS u32x2*)p = a; *(LAS u32x2*)(p + 8) = b; }
DI float wave_sum(float v) {
#pragma unroll
    for (int o = 1; o < 64; o <<= 1) v += __shfl_xor(v, o);
    return v;
}
DI void sincos_rad(float ang, float& s, float& c) {
    double r = (double)ang * 0.15915494309189535; r -= __builtin_rint(r); const float f = (float)r;
    s = __builtin_amdgcn_sinf(f); c = __builtin_amdgcn_cosf(f);
}

constexpr int BATCH = 8, SEQ = 8192, DM = 1024, MTOK = BATCH * SEQ;
constexpr int DFF = 2816, DPLE = 256;
constexpr float LN_EPS = 1e-5f, RMS_EPS = 1e-6f;
constexpr float ALPHA = 1.4142135623730951f;
constexpr float QSCALE = 0.07216878364870322f * 1.4426950408889634f;
constexpr size_t MiB = 1u << 20;
constexpr size_t WS_W = 1 * MiB, WS_DEC = 60 * MiB, WS_PB = 64 * MiB, WS_XB = 128 * MiB, WS_XF = 256 * MiB, WS_XB2 = 512 * MiB, WS_Y = 640 * MiB, WS_PP = 896 * MiB;
constexpr size_t WS_Q = 256 * MiB, WS_DQ = 448 * MiB, WS_DKV = 480 * MiB, WS_KN = 512 * MiB, WS_VT = 896 * MiB, WS_H = 512 * MiB;
constexpr size_t WS_HQ = 128 * MiB, WS_LOGF = 640 * MiB, WS_HK = 896 * MiB, WS_KHT = 256 * MiB, WS_HO = 640 * MiB, WS_HA = 768 * MiB;
constexpr size_t DO_O = 0, DO_KR = 128 * MiB, DO_SSQ = 136 * MiB, DO_HVT = 0, DO_HG = 128 * MiB, DO_HA = 0;
constexpr size_t WS_ST1 = 864 * MiB, WS_ST2 = 872 * MiB, WS_PART = 55 * MiB;
constexpr size_t C_CSF = 0, C_BWF = 2 * 5632, C_CSG = 4 * 5632, C_BWG = 4 * 5632 + 2 * 1024;
constexpr size_t P_FIN = 0, P_PG = 4 * 16 * 5632;
constexpr size_t W_DQKV = 0, W_UQ = W_DQKV + 768 * 1024, W_UK = W_UQ + 1536 * 256, W_UV = W_UK + 1024 * 256, W_WO = W_UV + 1024 * 256,
                 W_HIN = W_WO + 1024 * 1024, W_HO = W_HIN + 4096 * 1024, W_FIN = W_HO + 1024 * 1024, W_FDN = W_FIN + 2 * 5632 * 1024,
                 W_PPJ = W_FDN + 2 * 1024 * 2816, W_PG = W_PPJ + 2 * 1024 * 256, W_END = W_PG + 2 * 1024 * 1024;
static_assert(WS_W + W_END * 2 <= WS_DEC, "weights fit");
constexpr int LDS_BYTES = 147456 + 1024;
#define EPI_COMMON static constexpr bool PERM = true, AFTER_DRAIN = false;
#define EPI_SIG (const f32x4 (&acc)[2][2][4][2], const pg8::Unit& u, int wr, int wc, int fr, int fq) const
#define UNROLL _Pragma("unroll")
DI u32x4 pk8(const f32x4& a, const f32x4& b) { u32x4 w; w.x = pk2(a[0], a[1]); w.y = pk2(a[2], a[3]); w.z = pk2(b[0], b[1]); w.w = pk2(b[2], b[3]); return w; }
constexpr float ROPE_L2 = 0.4152410118609203f;

DI void rope_sc(float p, int i0, f32x4& s, f32x4& c) {
    UNROLL for (int j = 0; j < 4; ++j) { const float invf = exp2f(-(float)(i0 + j) * ROPE_L2); float sj, cj; sincos_rad(p * invf, sj, cj); s[j] = sj; c[j] = cj; }
}
DI u32x4 rope_apply(const f32x4& t1, const f32x4& t2, const f32x4& s, const f32x4& c) {
    const f32x4 o1 = t1 * c - t2 * s, o2 = t2 * c + t1 * s; return pk8(o1, o2);
}
struct EpiDown { EPI_COMMON bf16_t* DQ; bf16_t* DKV; bf16_t* KR; float* SSQ; const int* pos;
    DI void operator() EPI_SIG {
        const size_t row0 = (size_t)u.pm * 256 + wr * 64 + fr;
        if (u.pn < 2) {
            bf16_t* dst = u.pn == 0 ? DQ : DKV;
            UNROLL for (int ai = 0; ai < 2; ++ai) UNROLL for (int m = 0; m < 4; ++m) { const size_t row = row0 + ai * 128 + m * 16; float ss = 0.f;
                UNROLL for (int bj = 0; bj < 2; ++bj) { const f32x4 v0 = acc[ai][bj][m][0], v1 = acc[ai][bj][m][1];
                    ss += v0[0] * v0[0] + v0[1] * v0[1] + v0[2] * v0[2] + v0[3] * v0[3] + v1[0] * v1[0] + v1[1] * v1[1] + v1[2] * v1[2] + v1[3] * v1[3];
                    *(u32x4*)(dst + row * 256 + bj * 128 + wc * 32 + 8 * fq) = pk8(v0, v1); }
                ss += __shfl_xor(ss, 16); ss += __shfl_xor(ss, 32);
                if (fq == 0) SSQ[row * 8 + u.pn * 4 + wc] = ss; }
        } else if (wc < 2) {
            const int g = 4 * wc + fq;
            UNROLL for (int ai = 0; ai < 2; ++ai) UNROLL for (int m = 0; m < 4; ++m) { const size_t row = row0 + ai * 128 + m * 16;
                f32x4 sn, cs; rope_sc((float)pos[row], 4 * g, sn, cs); *(u32x4*)(KR + row * 64 + 8 * g) = rope_apply(acc[ai][0][m][0], acc[ai][0][m][1], sn, cs); }
        }
    }
};
struct EpiUQ { EPI_COMMON bf16_t* Q; const float* SSQ; const int* pos;
    DI void operator() EPI_SIG {
        const size_t row0 = (size_t)u.pm * 256 + wr * 64 + fr;
        float rsa[2][4];
        UNROLL for (int ai = 0; ai < 2; ++ai) UNROLL for (int m = 0; m < 4; ++m) { const f32x4 sq = *(const f32x4*)(SSQ + (row0 + ai * 128 + m * 16) * 8); rsa[ai][m] = rsqrtf((sq[0] + sq[1] + sq[2] + sq[3]) * (1.0f / 256.0f) + RMS_EPS); }
        UNROLL for (int ai = 0; ai < 2; ++ai) UNROLL for (int m = 0; m < 4; ++m) { const size_t row = row0 + ai * 128 + m * 16;
            const float rstd = rsa[ai][m];
            if (u.pn < 4) {
                UNROLL for (int bj = 0; bj < 2; ++bj) { const int h = 2 * u.pn + bj;
                    *(u32x4*)(Q + row * 1536 + h * 192 + wc * 32 + 8 * fq) = pk8(acc[ai][bj][m][0] * rstd, acc[ai][bj][m][1] * rstd); }
            } else {
                const int g = 4 * (wc & 1) + fq; f32x4 sn, cs; rope_sc((float)pos[row], 4 * g, sn, cs); sn = sn * rstd; cs = cs * rstd;
                UNROLL for (int bj = 0; bj < 2; ++bj) { const int cc = 256 * (u.pn - 4) + 128 * bj + 32 * wc, h = cc >> 6;
                    *(u32x4*)(Q + row * 1536 + h * 192 + 128 + 8 * g) = rope_apply(acc[ai][bj][m][0], acc[ai][bj][m][1], sn, cs); }
            }
        }
    }
};
struct EpiUK { EPI_COMMON bf16_t* O; const float* SSQ;
    DI void operator() EPI_SIG {
        const size_t row0 = (size_t)u.pm * 256 + wr * 64 + fr; const int col0 = u.pn * 256 + wc * 32 + 8 * fq;
        float rsa[2][4];
        UNROLL for (int ai = 0; ai < 2; ++ai) UNROLL for (int m = 0; m < 4; ++m) { const f32x4 sq = *(const f32x4*)(SSQ + (row0 + ai * 128 + m * 16) * 8 + 4); rsa[ai][m] = rsqrtf((sq[0] + sq[1] + sq[2] + sq[3]) * (1.0f / 256.0f) + RMS_EPS); }
        UNROLL for (int ai = 0; ai < 2; ++ai) UNROLL for (int m = 0; m < 4; ++m) { const size_t row = row0 + ai * 128 + m * 16;
            const float rstd = rsa[ai][m];
            UNROLL for (int bj = 0; bj < 2; ++bj) *(u32x4*)(O + row * 1024 + col0 + bj * 128) = pk8(acc[ai][bj][m][0] * rstd, acc[ai][bj][m][1] * rstd); }
    }
};
struct EpiVT { EPI_COMMON bf16_t* O; const float* SSQ;
    DI void operator() EPI_SIG {
        const size_t row0 = (size_t)u.pm * 256 + wr * 64 + fr; const int col0 = u.pn * 256 + wc * 32 + 8 * fq;
        UNROLL for (int bj = 0; bj < 2; ++bj) { f32x4 rs[2];
            UNROLL for (int n = 0; n < 2; ++n) UNROLL for (int j = 0; j < 4; ++j) { const size_t tok = (size_t)col0 + bj * 128 + 4 * n + j;
                const f32x4 sq = *(const f32x4*)(SSQ + tok * 8 + 4); rs[n][j] = rsqrtf((sq[0] + sq[1] + sq[2] + sq[3]) * (1.0f / 256.0f) + RMS_EPS); }
            UNROLL for (int ai = 0; ai < 2; ++ai) UNROLL for (int m = 0; m < 4; ++m) { const size_t row = row0 + ai * 128 + m * 16;
                const size_t col = (size_t)col0 + bj * 128; *(u32x4*)(O + ((col >> 6) * 1024 + row) * 64 + (col & 63)) = pk8(acc[ai][bj][m][0] * rs[0], acc[ai][bj][m][1] * rs[1]); } }
    }
};
struct EpiRes { EPI_COMMON const float* res; float* Y;
    DI void operator() EPI_SIG {
        const size_t row0 = (size_t)u.pm * 256 + wr * 64 + fr; const int col0 = u.pn * 256 + wc * 32 + 8 * fq;
        UNROLL for (int ai = 0; ai < 2; ++ai) UNROLL for (int m = 0; m < 4; ++m) { const size_t row = row0 + ai * 128 + m * 16;
            UNROLL for (int bj = 0; bj < 2; ++bj) UNROLL for (int n = 0; n < 2; ++n) { const size_t idx = row * 1024 + col0 + bj * 128 + 4 * n;
                const f32x4 r = *(const f32x4*)(res + idx); *(f32x4*)(Y + idx) = r * ALPHA + acc[ai][bj][m][n]; } }
    }
};
struct EpiSwiglu { EPI_COMMON bf16_t* H;
    DI void operator() EPI_SIG {
        const size_t row0 = (size_t)u.pm * 256 + wr * 64 + fr; const int col0 = u.pn * 128 + wc * 32 + 8 * fq;
        UNROLL for (int ai = 0; ai < 2; ++ai) UNROLL for (int m = 0; m < 4; ++m) { const size_t row = row0 + ai * 128 + m * 16;
            f32x4 h0, h1;
            UNROLL for (int j = 0; j < 4; ++j) { h0[j] = siluf_(acc[ai][0][m][0][j]) * acc[ai][1][m][0][j]; h1[j] = siluf_(acc[ai][0][m][1][j]) * acc[ai][1][m][1][j]; }
            *(u32x4*)(H + row * DFF + col0) = pk8(h0, h1); }
    }
};
template <bool CHUNKED> struct EpiBf16 { EPI_COMMON bf16_t* O; size_t ldc;
    DI void operator() EPI_SIG {
        const size_t row0 = (size_t)u.pm * 256 + wr * 64 + fr; const int col0 = u.pn * 256 + wc * 32 + 8 * fq;
        UNROLL for (int ai = 0; ai < 2; ++ai) UNROLL for (int m = 0; m < 4; ++m) { const size_t row = row0 + ai * 128 + m * 16;
            UNROLL for (int bj = 0; bj < 2; ++bj) { const size_t col = (size_t)col0 + bj * 128;
                bf16_t* dst = CHUNKED ? O + ((col >> 6) * 1024 + row) * 64 + (col & 63) : O + row * ldc + col;
                *(u32x4*)dst = pk8(acc[ai][bj][m][0], acc[ai][bj][m][1]); } }
    }
};
struct EpiGate { EPI_COMMON const float* XF; const bf16_t* PP; float* OF; bf16_t* OB;
    DI void operator() EPI_SIG {
        const size_t row0 = (size_t)u.pm * 256 + wr * 64 + fr; const int col0 = u.pn * 256 + wc * 32 + 8 * fq;
        UNROLL for (int ai = 0; ai < 2; ++ai) UNROLL for (int m = 0; m < 4; ++m) { const size_t row = row0 + ai * 128 + m * 16;
            UNROLL for (int bj = 0; bj < 2; ++bj) { const size_t idx = row * 1024 + col0 + bj * 128;
                const u32x4 pp = *(const u32x4*)(PP + idx); const f32x4 x0 = *(const f32x4*)(XF + idx), x1 = *(const f32x4*)(XF + idx + 4);
                const f32x4 a0 = acc[ai][bj][m][0], a1 = acc[ai][bj][m][1]; f32x4 o0, o1;
                o0[0] = x0[0] + sigmoidf_(a0[0]) * bflo(pp.x); o0[1] = x0[1] + sigmoidf_(a0[1]) * bfhi(pp.x); o0[2] = x0[2] + sigmoidf_(a0[2]) * bflo(pp.y); o0[3] = x0[3] + sigmoidf_(a0[3]) * bfhi(pp.y);
                o1[0] = x1[0] + sigmoidf_(a1[0]) * bflo(pp.z); o1[1] = x1[1] + sigmoidf_(a1[1]) * bfhi(pp.z); o1[2] = x1[2] + sigmoidf_(a1[2]) * bflo(pp.w); o1[3] = x1[3] + sigmoidf_(a1[3]) * bfhi(pp.w);
                *(f32x4*)(OF + idx) = o0; *(f32x4*)(OF + idx + 4) = o1;
                if (OB) *(u32x4*)(OB + idx) = pk8(o0, o1); } }
    }
};
typedef float f32x2v __attribute__((ext_vector_type(2)));
DI void row_stats(const f32x2v* st, size_t row, int fq, float& mu, float& rstd) {
    const f32x4 a = *(const f32x4*)(st + row * 16 + 4 * fq), b = *(const f32x4*)(st + row * 16 + 4 * fq + 2);
    float s1 = (a[0] + a[2]) + (b[0] + b[2]), s2 = (a[1] + a[3]) + (b[1] + b[3]);
    s1 += __shfl_xor(s1, 16); s1 += __shfl_xor(s1, 32); s2 += __shfl_xor(s2, 16); s2 += __shfl_xor(s2, 32);
    mu = s1 * (1.0f / 1024.0f); const float var = fmaxf(s2 * (1.0f / 1024.0f) - mu * mu, 0.f); rstd = rsqrtf(var + LN_EPS);
}
DI void unpack8(const u32x4& p, f32x4& a, f32x4& b) { a[0] = bflo(p.x); a[1] = bfhi(p.x); a[2] = bflo(p.y); a[3] = bfhi(p.y); b[0] = bflo(p.z); b[1] = bfhi(p.z); b[2] = bflo(p.w); b[3] = bfhi(p.w); }
template <bool LNRES, bool RESBF> struct EpiRes2 { EPI_COMMON const void* res; const f32x2v* stp; const float* g; const float* b; bf16_t* YB; f32x2v* sto;
    DI void operator() EPI_SIG {
        const size_t row0 = (size_t)u.pm * 256 + wr * 64 + fr; const int col0 = u.pn * 256 + wc * 32 + 8 * fq;
        constexpr int MB = RESBF ? 4 : 2;
        UNROLL for (int ai = 0; ai < 2; ++ai) UNROLL for (int mp = 0; mp < 4 / MB; ++mp) {
            float mu[MB], rstd[MB]; u32x4 rb[MB][2]; f32x4 rf[RESBF ? 1 : MB][2][2];
            UNROLL for (int mm = 0; mm < MB; ++mm) { const size_t row = row0 + ai * 128 + (MB * mp + mm) * 16; mu[mm] = 0.f; rstd[mm] = 1.f; if (LNRES) row_stats(stp, row, fq, mu[mm], rstd[mm]);
                UNROLL for (int bj = 0; bj < 2; ++bj) { const size_t idx = row * 1024 + col0 + bj * 128;
                    if (RESBF) rb[mm][bj] = *(const u32x4*)((const bf16_t*)res + idx);
                    else { rf[RESBF ? 0 : mm][bj][0] = *(const f32x4*)((const float*)res + idx); rf[RESBF ? 0 : mm][bj][1] = *(const f32x4*)((const float*)res + idx + 4); } } }
            UNROLL for (int mm = 0; mm < MB; ++mm) { const int m = MB * mp + mm; const size_t row = row0 + ai * 128 + m * 16;
                float s1 = 0.f, s2 = 0.f;
                UNROLL for (int bj = 0; bj < 2; ++bj) { f32x4 yv[2], rr[2];
                    if (RESBF) unpack8(rb[mm][bj], rr[0], rr[1]); else { rr[0] = rf[RESBF ? 0 : mm][bj][0]; rr[1] = rf[RESBF ? 0 : mm][bj][1]; }
                    UNROLL for (int n = 0; n < 2; ++n) { const int col = col0 + bj * 128 + 4 * n;
                        f32x4 r1 = rr[n];
                        if (LNRES) r1 = (r1 - mu[mm]) * rstd[mm] * *(const f32x4*)(g + col) + *(const f32x4*)(b + col);
                        const f32x4 y = r1 * ALPHA + acc[ai][bj][m][n]; yv[n] = y;
                        s1 += (y[0] + y[1]) + (y[2] + y[3]); s2 += (y[0] * y[0] + y[1] * y[1]) + (y[2] * y[2] + y[3] * y[3]); }
                    *(u32x4*)(YB + row * 1024 + col0 + bj * 128) = pk8(yv[0], yv[1]); }
                s1 += __shfl_xor(s1, 16); s1 += __shfl_xor(s1, 32); s2 += __shfl_xor(s2, 16); s2 += __shfl_xor(s2, 32);
                if (fq == 0) { f32x2v o; o[0] = s1; o[1] = s2; sto[row * 16 + u.pn * 4 + wc] = o; } } }
    }
};
struct EpiSwigluLN { EPI_COMMON bf16_t* H; const f32x2v* st; const float* cs; const float* bw;
    DI void operator() EPI_SIG {
        const size_t row0 = (size_t)u.pm * 256 + wr * 64 + fr; const int col0 = u.pn * 128 + wc * 32 + 8 * fq, pc0 = u.pn * 256 + wc * 32 + 8 * fq;
        f32x4 csv[2][2], bwv[2][2];
        UNROLL for (int bj = 0; bj < 2; ++bj) UNROLL for (int n = 0; n < 2; ++n) { csv[bj][n] = *(const f32x4*)(cs + pc0 + bj * 128 + 4 * n); bwv[bj][n] = *(const f32x4*)(bw + pc0 + bj * 128 + 4 * n); }
        float mua[2][4], rsa[2][4];
        UNROLL for (int ai = 0; ai < 2; ++ai) UNROLL for (int m = 0; m < 4; ++m) row_stats(st, row0 + ai * 128 + m * 16, fq, mua[ai][m], rsa[ai][m]);
        UNROLL for (int ai = 0; ai < 2; ++ai) UNROLL for (int m = 0; m < 4; ++m) { const size_t row = row0 + ai * 128 + m * 16;
            const float mu = mua[ai][m], rstd = rsa[ai][m];
            f32x4 h[2];
            UNROLL for (int n = 0; n < 2; ++n) { const f32x4 gp = (acc[ai][0][m][n] - csv[0][n] * mu) * rstd + bwv[0][n], up = (acc[ai][1][m][n] - csv[1][n] * mu) * rstd + bwv[1][n];
                UNROLL for (int j = 0; j < 4; ++j) h[n][j] = siluf_(gp[j]) * up[j]; }
            *(u32x4*)(H + row * DFF + col0) = pk8(h[0], h[1]); }
    }
};
struct EpiGateLN { EPI_COMMON const bf16_t* Y2; const f32x2v* st; const float* g; const float* b; const float* cs; const float* bw; const bf16_t* PP; float* OF; bf16_t* OB;
    DI void operator() EPI_SIG {
        const size_t row0 = (size_t)u.pm * 256 + wr * 64 + fr; const int col0 = u.pn * 256 + wc * 32 + 8 * fq;
        UNROLL for (int ai = 0; ai < 2; ++ai) UNROLL for (int mp = 0; mp < 2; ++mp) {
            float mu[2], rstd[2]; u32x4 yv[2][2], ppv[2][2];
            UNROLL for (int mm = 0; mm < 2; ++mm) { const size_t row = row0 + ai * 128 + (2 * mp + mm) * 16; row_stats(st, row, fq, mu[mm], rstd[mm]);
                UNROLL for (int bj = 0; bj < 2; ++bj) { const size_t idx = row * 1024 + col0 + bj * 128; ppv[mm][bj] = *(const u32x4*)(PP + idx); yv[mm][bj] = *(const u32x4*)(Y2 + idx); } }
            UNROLL for (int mm = 0; mm < 2; ++mm) { const int m = 2 * mp + mm; const size_t row = row0 + ai * 128 + m * 16;
                UNROLL for (int bj = 0; bj < 2; ++bj) { const int col = col0 + bj * 128; const size_t idx = row * 1024 + col;
                    f32x4 ppf[2], yf[2]; unpack8(ppv[mm][bj], ppf[0], ppf[1]); unpack8(yv[mm][bj], yf[0], yf[1]);
                    f32x4 o[2];
                    UNROLL for (int n = 0; n < 2; ++n) { const int c = col + 4 * n;
                        const f32x4 xf = (yf[n] - mu[mm]) * rstd[mm] * *(const f32x4*)(g + c) + *(const f32x4*)(b + c);
                        const f32x4 gp = (acc[ai][bj][m][n] - *(const f32x4*)(cs + c) * mu[mm]) * rstd[mm] + *(const f32x4*)(bw + c);
                        UNROLL for (int j = 0; j < 4; ++j) o[n][j] = xf[j] + sigmoidf_(gp[j]) * ppf[n][j];
                        if (OF) *(f32x4*)(OF + idx + 4 * n) = o[n]; }
                    if (OB) *(u32x4*)(OB + idx) = pk8(o[0], o[1]); } } }
    }
};
struct EpiHin { EPI_COMMON bf16_t* QT; bf16_t* KT; bf16_t* KHT; float* DEC; bf16_t* HG; const float* logits;
    DI void operator() EPI_SIG {
        const size_t row0 = (size_t)u.pm * 256 + wr * 64 + fr;
        if (u.pn >= 8) {
            const int col0 = (u.pn - 8) * 256 + wc * 32 + 8 * fq;
            UNROLL for (int ai = 0; ai < 2; ++ai) UNROLL for (int m = 0; m < 4; ++m) { const size_t row = row0 + ai * 128 + m * 16;
                UNROLL for (int bj = 0; bj < 2; ++bj) { f32x4 s0, s1;
                    UNROLL for (int j = 0; j < 4; ++j) { s0[j] = siluf_(acc[ai][bj][m][0][j]); s1[j] = siluf_(acc[ai][bj][m][1][j]); }
                    *(u32x4*)(HG + row * 1024 + col0 + bj * 128) = pk8(s0, s1); } }
            return;
        }
        const int h = u.pn, d0 = wc * 32 + 8 * fq, lane = fq * 16 + fr;
        f32x4 lb[2];
        UNROLL for (int n = 0; n < 2; ++n) UNROLL for (int j = 0; j < 4; ++j) { const int c = h * 128 + d0 + 4 * n + j; lb[n][j] = __builtin_amdgcn_rcpf(1.0f + __expf(logits[c] - logits[1024 + c])); }
        UNROLL for (int ai = 0; ai < 2; ++ai) UNROLL for (int n = 0; n < 2; ++n) { unsigned wq0[4], wk0[4]; UNROLL for (int jp = 0; jp < 2; ++jp) {
            float Gc[4][2], kk[4][2];
            UNROLL for (int m = 0; m < 4; ++m) UNROLL for (int jj = 0; jj < 2; ++jj) {
                const float l = lb[n][2 * jp + jj], fv = l + (1.0f - l) * sigmoidf_(acc[ai][1][m][n][2 * jp + jj]); Gc[m][jj] = __logf(fv); kk[m][jj] = 1.0f - fv; }
            UNROLL for (int k = 1; k < 16; k <<= 1)
                UNROLL for (int m = 0; m < 4; ++m) UNROLL for (int jj = 0; jj < 2; ++jj) { const float t = __shfl_up(Gc[m][jj], k, 16); if (fr >= k) Gc[m][jj] += t; }
            float off[2] = {0.f, 0.f};
            UNROLL for (int m = 0; m < 4; ++m) UNROLL for (int jj = 0; jj < 2; ++jj) { const float tm = __shfl(Gc[m][jj], (lane & 48) | 15); Gc[m][jj] += off[jj]; off[jj] += tm; }
            const size_t cgi = (size_t)u.pm * 4 + ai * 2 + wr; const int dn = d0 + 4 * n + 2 * jp;
            bf16_t* khp = KHT + ((cgi * 8 + h) * 128 + dn) * 64 + fr;
            const float eoff[2] = {__expf(off[0]), __expf(off[1])};
            UNROLL for (int m = 0; m < 4; ++m) { const size_t row = row0 + ai * 128 + m * 16; float qt[2], kt[2];
                UNROLL for (int jj = 0; jj < 2; ++jj) { const float eng = __expf(-Gc[m][jj]), k = kk[m][jj];
                    qt[jj] = siluf_(acc[ai][0][m][n][2 * jp + jj]) * __builtin_amdgcn_rcpf(eng); kt[jj] = k * eng;
                    khp[(size_t)jj * 64 + 16 * m] = f2bf(kt[jj] * eoff[jj]); }
                if (jp == 0) { wq0[m] = pk2(qt[0], qt[1]); wk0[m] = pk2(kt[0], kt[1]); }
                else { u32x2 wq, wk; wq.x = wq0[m]; wq.y = pk2(qt[0], qt[1]); wk.x = wk0[m]; wk.y = pk2(kt[0], kt[1]);
                    *(u32x2*)(QT + row * 1024 + h * 128 + dn - 2) = wq; *(u32x2*)(KT + row * 1024 + h * 128 + dn - 2) = wk; } }
            if (fr == 0) { f32x2v e0; e0[0] = eoff[0]; e0[1] = eoff[1]; *(f32x2v*)(DEC + cgi * 1024 + h * 128 + dn) = e0; }
        } }
    }
};
enum { MAT_ID = 0, MAT_DQKV, MAT_UQ, MAT_UK, MAT_UV, MAT_HIN, MAT_FIN };
template <int MAT> DI int mapcol(int n) {
    if (MAT == MAT_DQKV) { if (n < 512) return n; if (n >= 576) return -1; const int w = n - 512, g = w >> 3, i8 = w & 7; return 512 + (i8 < 4 ? 4 * g + i8 : 32 + 4 * g + (i8 - 4)); }
    if (MAT == MAT_UQ) { if (n < 1024) return (n >> 7) * 192 + (n & 127); const int w = n - 1024, h = w >> 6, r = w & 63, g = r >> 3, i8 = r & 7; return h * 192 + 128 + (i8 < 4 ? 4 * g + i8 : 32 + 4 * g + (i8 - 4)); }
    if (MAT == MAT_UK) return (n >> 7) * 256 + (n & 127);
    if (MAT == MAT_UV) return (n >> 7) * 256 + 128 + (n & 127);
    if (MAT == MAT_HIN) { if (n < 2048) { const int t = n >> 8, r = n & 255; return r < 128 ? t * 128 + r : 1024 + t * 128 + (r - 128); } if (n < 3072) return n + 1024; return n - 1024; }
    if (MAT == MAT_FIN) { const int t = n >> 8, r = n & 255; return r < 128 ? 128 * t + r : DFF + 128 * t + (r - 128); }
    return n;
}
template <int MAT, bool STATS = false> DI void transpose_mat(const float* W, int K, int Nsrc, int Ndst, bf16_t* WT, const float* kscale, float sc, LAS float* scr, int gw, int NGW, int lane,
                                                             const float* kbias = nullptr, float* PC = nullptr, float* PB = nullptr) {
    const int nblk = Ndst / 32, items = (K / 64) * nblk;
    for (int it = gw; it < items; it += NGW) {
        const int kb = it / nblk, nb = it % nblk, k0 = 64 * kb, n0 = 32 * nb;
        const int src = mapcol<MAT>(n0 + (lane & 31));
        float pc = 0.f, pb = 0.f;
        float wv[32];
#pragma unroll
        for (int i = 0; i < 32; ++i) { const int kk = 2 * i + (lane >> 5); wv[i] = (src >= 0) ? __builtin_nontemporal_load(W + (size_t)(k0 + kk) * Nsrc + src) : 0.f; }
#pragma unroll
        for (int i = 0; i < 32; ++i) { const int kk = 2 * i + (lane >> 5); float v = wv[i] * sc;
            if (src >= 0) { if (STATS) pb += v * kbias[k0 + kk]; if (kscale) v *= kscale[k0 + kk]; if (STATS) pc += v; }
            scr[kk * 33 + (lane & 31)] = v; }
        if (STATS) { pc += __shfl_xor(pc, 32); pb += __shfl_xor(pb, 32); if (lane < 32) { PC[(size_t)kb * Ndst + n0 + lane] = pc; PB[(size_t)kb * Ndst + n0 + lane] = pb; } }
        asm volatile("s_waitcnt lgkmcnt(0)" ::: "memory");
        const int c = lane & 7;
#pragma unroll
        for (int j = 0; j < 4; ++j) { const int n = (lane >> 3) + 8 * j; const LAS float* s = scr + (8 * c) * 33 + n;
            u32x4 o; o.x = pk2(s[0 * 33], s[1 * 33]); o.y = pk2(s[2 * 33], s[3 * 33]); o.z = pk2(s[4 * 33], s[5 * 33]); o.w = pk2(s[6 * 33], s[7 * 33]);
            *(u32x4*)(WT + (size_t)(n0 + n) * K + k0 + 8 * c) = o; }
        asm volatile("s_waitcnt lgkmcnt(0)" ::: "memory");
    }
}
DI void cast_bf16(const float* src, bf16_t* dst, size_t n, size_t gt, size_t NGT) {
    for (size_t i = gt; i < n / 8; i += NGT) { const f32x4 a = *(const f32x4*)(src + 8 * i), b = *(const f32x4*)(src + 8 * i + 4); *(u32x4*)(dst + 8 * i) = pk8(a, b); }
}
DI void ln_pass(const float* Y, const float* g, const float* b, float* XF, bf16_t* XB, int gw, int NGW, int lane) {
    f32x4 gv[4], bv[4];
#pragma unroll
    for (int j = 0; j < 4; ++j) { gv[j] = *(const f32x4*)(g + 4 * lane + 256 * j); bv[j] = *(const f32x4*)(b + 4 * lane + 256 * j); }
    for (int row = gw; row < MTOK; row += NGW) {
        const float* y = Y + (size_t)row * 1024 + 4 * lane; f32x4 v[4]; float s = 0.f;
#pragma unroll
        for (int j = 0; j < 4; ++j) { v[j] = *(const f32x4*)(y + 256 * j); s += (v[j][0] + v[j][1]) + (v[j][2] + v[j][3]); }
        const float mean = wave_sum(s) * (1.0f / 1024.0f); float s2 = 0.f;
#pragma unroll
        for (int j = 0; j < 4; ++j) { v[j] = v[j] - mean; s2 += (v[j][0] * v[j][0] + v[j][1] * v[j][1]) + (v[j][2] * v[j][2] + v[j][3] * v[j][3]); }
        const float rstd = rsqrtf(wave_sum(s2) * (1.0f / 1024.0f) + LN_EPS);
#pragma unroll
        for (int j = 0; j < 4; ++j) { const f32x4 o = v[j] * rstd * gv[j] + bv[j]; const size_t idx = (size_t)row * 1024 + 4 * lane + 256 * j;
            *(f32x4*)(XF + idx) = o; u32x2 w; w.x = pk2(o[0], o[1]); w.y = pk2(o[2], o[3]); *(u32x2*)(XB + idx) = w; }
    }
}
constexpr int AT_KP = 400, AT_VP = 136, AT_VOFF = 64 * AT_KP, AT_BUF = AT_VOFF + 128 * AT_VP;
static_assert(2 * AT_BUF <= 131072, "attention LDS");
DI void attn_phase(ldsp lds, const bf16_t* Q, const bf16_t* KN, const bf16_t* KR, const bf16_t* VT, bf16_t* O, int vcu, int G) {
    int tid_ = threadIdx.x; asm volatile("" : "+v"(tid_));
    const int tid = tid_, wid = __builtin_amdgcn_readfirstlane(tid >> 6), lane = tid & 63, l31 = lane & 31, hh = lane >> 5;
    for (int pr = vcu; pr < 1024; pr += G) {
        const int bh = pr >> 4, jj = pr & 15, b = bh >> 3, h = bh & 7;
        const size_t tok0 = (size_t)b * SEQ;
#pragma unroll 1
        for (int half = 0; half < 2; ++half) {
            const int qb = half == 0 ? 31 - jj : jj;
            const int q0 = qb * 256 + wid * 32;
            bf16x8 qf[12];
            { const bf16_t* qp = Q + (tok0 + q0 + l31) * 1536 + h * 192 + hh * 8;
#pragma unroll
              for (int ks = 0; ks < 12; ++ks) qf[ks] = *(const bf16x8*)(qp + ks * 16); }
            f32x16 o[4];
#pragma unroll
            for (int d = 0; d < 4; ++d)
#pragma unroll
                for (int r = 0; r < 16; ++r) o[d][r] = 0.f;
            float mrun = -1e30f, lrun = 0.f;
            const int ntiles = (qb + 1) * 4;
            u32x4 kreg[3], vreg[2];
            const int srow = tid >> 3, scp = tid & 7;
            const bf16_t* knp = KN + (tok0 + srow) * 1024 + h * 128 + scp * 8;
            const bf16_t* krp = KR + (tok0 + srow) * 64 + scp * 8;
            const bf16_t* vtp = VT + ((tok0 >> 6) * 1024 + h * 128 + srow) * 64 + scp * 8;
            const int kdst = srow * AT_KP + scp * 16, vdst = AT_VOFF + srow * AT_VP + scp * 16;
#define AT_LOAD(t) do { const bf16_t* kn_ = knp + (size_t)(t) * 65536; kreg[0] = *(const u32x4*)(kn_); kreg[1] = *(const u32x4*)(kn_ + 64); kreg[2] = *(const u32x4*)(krp + (size_t)(t) * 4096); \
                        const bf16_t* vt_ = vtp + (size_t)(t) * 65536; vreg[0] = *(const u32x4*)(vt_); vreg[1] = *(const u32x4*)(vt_ + 4096); } while (0)
#define AT_STORE(buf) do { ldsp base_ = lds + (buf) * AT_BUF; *(LAS u32x4*)(base_ + kdst) = kreg[0]; *(LAS u32x4*)(base_ + kdst + 128) = kreg[1]; *(LAS u32x4*)(base_ + kdst + 256) = kreg[2]; \
                           lds_w8x2(base_ + vdst, vreg[0]); lds_w8x2(base_ + vdst + 64 * AT_VP, vreg[1]); } while (0)
            AT_LOAD(0); AT_STORE(0); __syncthreads();
#pragma unroll 1
            for (int t = 0; t < ntiles; ++t) {
                const int buf = t & 1, key0 = t * 64;
                if (t + 1 < ntiles) AT_LOAD(t + 1);
                if (key0 <= q0 + 31) {
                    ldsp Lb = lds + buf * AT_BUF;
                    f32x16 s0, s1;
#pragma unroll
                    for (int r = 0; r < 16; ++r) { s0[r] = 0.f; s1[r] = 0.f; }
                    ldsp kb = Lb + l31 * AT_KP + hh * 16;
                    bf16x8 kf[6];
#pragma unroll
                    for (int i = 0; i < 6; ++i) kf[i] = *(const LAS bf16x8*)(kb + (i & 1) * 32 * AT_KP + (i >> 1) * 32);
#pragma unroll
                    for (int i = 0; i < 24; ++i) { const bf16x8 cur = kf[i % 6];
                        if (i + 6 < 24) kf[i % 6] = *(const LAS bf16x8*)(kb + ((i + 6) & 1) * 32 * AT_KP + ((i + 6) >> 1) * 32);
                        if (i & 1) s1 = MFMA32(cur, qf[i >> 1], s1); else s0 = MFMA32(cur, qf[i >> 1], s0); }
#pragma unroll
                    for (int i = 0; i < 6; ++i) __builtin_amdgcn_sched_group_barrier(0x100, 1, 0);
#pragma unroll
                    for (int i = 0; i < 18; ++i) { __builtin_amdgcn_sched_group_barrier(0x008, 1, 0); __builtin_amdgcn_sched_group_barrier(0x100, 1, 0); }
#pragma unroll
                    for (int i = 0; i < 6; ++i) __builtin_amdgcn_sched_group_barrier(0x008, 1, 0);
                    if (key0 + 63 > q0) {
                        const int qpos = q0 + l31;
#pragma unroll
                        for (int r = 0; r < 16; ++r) { const int key = key0 + crow(r, hh); if (key > qpos) s0[r] = -1e30f; if (key + 32 > qpos) s1[r] = -1e30f; }
                    }
                    float mx = s0[0];
#pragma unroll
                    for (int r = 1; r < 16; ++r) mx = fmaxf(mx, s0[r]);
#pragma unroll
                    for (int r = 0; r < 16; ++r) mx = fmaxf(mx, s1[r]);
                    { auto t_ = __builtin_amdgcn_permlane32_swap(__float_as_uint(mx), __float_as_uint(mx), false, false); mx = fmaxf(__uint_as_float(t_[0]), __uint_as_float(t_[1])); }
                    if (__builtin_amdgcn_ballot_w64(mx - mrun > 8.0f) != 0ull) {
                        const float mn = fmaxf(mrun, mx), al = __builtin_amdgcn_exp2f(mrun - mn); mrun = mn; lrun *= al;
#pragma unroll
                        for (int d = 0; d < 4; ++d)
#pragma unroll
                            for (int r = 0; r < 16; ++r) o[d][r] *= al;
                    }
                    float rs = 0.f;
#pragma unroll
                    for (int r = 0; r < 16; ++r) { s0[r] = __builtin_amdgcn_exp2f(s0[r] - mrun); s1[r] = __builtin_amdgcn_exp2f(s1[r] - mrun); rs += s0[r] + s1[r]; }
                    lrun += rs;
                    bf16x8 pa[2][2];
                    pa[0][0] = pack8(s0, 0); pa[0][1] = pack8(s0, 1); pa[1][0] = pack8(s1, 0); pa[1][1] = pack8(s1, 1);
#pragma unroll
                    for (int kb2 = 0; kb2 < 2; ++kb2)
#pragma unroll
                        for (int s2 = 0; s2 < 2; ++s2)
#pragma unroll
                            for (int d = 0; d < 4; ++d) {
                                const bf16x8 va = lds_8x2(Lb + AT_VOFF + (d * 32 + l31) * AT_VP + (kb2 * 32 + 16 * s2 + 4 * hh) * 2, 16);
                                o[d] = MFMA32(va, pa[kb2][s2], o[d]); }
                }
                if (t + 1 < ntiles) AT_STORE(buf ^ 1);
                __syncthreads();
            }
#undef AT_LOAD
#undef AT_STORE
            lrun += __shfl_xor(lrun, 32);
            const float inv = 1.0f / lrun;
            bf16_t* op = O + (tok0 + q0 + l31) * 1024 + h * 128 + 4 * hh;
#pragma unroll
            for (int d = 0; d < 4; ++d)
#pragma unroll
                for (int g = 0; g < 4; ++g) { u32x2 w; w.x = pk2(o[d][4 * g] * inv, o[d][4 * g + 1] * inv); w.y = pk2(o[d][4 * g + 2] * inv, o[d][4 * g + 3] * inv);
                    *(u32x2*)(op + d * 32 + 8 * g) = w; }
        }
    }
}
DI void hgrn_prep(ldsp lds, const float* LOGF, bf16_t* HQ, bf16_t* HK, bf16_t* KHT, float* DEC, int vcu, int G) {
    int tid_ = threadIdx.x; asm volatile("" : "+v"(tid_));
    const int tid = tid_, tg = tid >> 6, cl = tid & 63;
    LAS float* part = (LAS float*)lds;
    int par = 0;
    float lf[8], nlf[8]; unsigned short qv[8], kv[8], nqv[8], nkv[8];
#define HP_LOAD(it_, L, Q_, K_) do { const int cgi_ = (it_) >> 4, col_ = ((it_) & 15) * 64 + cl; const size_t b_ = ((size_t)cgi_ * 64 + 8 * tg) * 1024 + col_; \
        _Pragma("unroll") for (int tt = 0; tt < 8; ++tt) { L[tt] = LOGF[b_ + (size_t)tt * 1024]; Q_[tt] = HQ[b_ + (size_t)tt * 1024]; K_[tt] = HK[b_ + (size_t)tt * 1024]; } } while (0)
    if (vcu < 16384) HP_LOAD(vcu, lf, qv, kv);
#pragma unroll 1
    for (int it = vcu; it < 16384; it += G) {
        const int cgi = it >> 4, col = (it & 15) * 64 + cl; const size_t base = ((size_t)cgi * 64 + 8 * tg) * 1024 + col;
        const bool has_next = it + G < 16384;
        if (has_next) HP_LOAD(it + G, nlf, nqv, nkv);
#pragma unroll
        for (int tt = 1; tt < 8; ++tt) lf[tt] += lf[tt - 1];
        part[par * 512 + tg * 64 + cl] = lf[7];
        __syncthreads();
        float off = 0.f, gl = 0.f;
#pragma unroll
        for (int g2 = 0; g2 < 8; ++g2) { const float v = part[par * 512 + g2 * 64 + cl]; gl += v; if (g2 < tg) off += v; }
        float khv[8];
#pragma unroll
        for (int tt = 0; tt < 8; ++tt) { const float g = off + lf[tt]; const float q = bf2f(qv[tt]), k = bf2f(kv[tt]); const size_t idx = base + (size_t)tt * 1024;
            HQ[idx] = f2bf(q * __expf(g)); HK[idx] = f2bf(k * __expf(-g)); khv[tt] = k * __expf(gl - g); }
        u32x4 w; w.x = pk2(khv[0], khv[1]); w.y = pk2(khv[2], khv[3]); w.z = pk2(khv[4], khv[5]); w.w = pk2(khv[6], khv[7]);
        *(u32x4*)(KHT + (((size_t)cgi * 8 + (col >> 7)) * 128 + (col & 127)) * 64 + 8 * tg) = w;
        if (tg == 0) DEC[(size_t)cgi * 1024 + col] = __expf(gl);
        par ^= 1;
        if (has_next) {
#pragma unroll
            for (int tt = 0; tt < 8; ++tt) { lf[tt] = nlf[tt]; qv[tt] = nqv[tt]; kv[tt] = nkv[tt]; }
        }
    }
#undef HP_LOAD
}
constexpr int HS_QT = 0, HS_KT = 17408, HS_KHT = 34816, HS_VT = 52224, HS_DEC = 56576, HS_BUF = 57344, HS_QP = 272, HS_P = 136, HS_RED = 2 * HS_BUF;
static_assert(HS_RED + 32768 <= 147456, "scan LDS");
DI void hgrn_scan(ldsp lds, const bf16_t* QT, const bf16_t* KT, const bf16_t* KHT, const bf16_t* HVT, const float* DEC, bf16_t* HO, int vcu, int G) {
    int tid_ = threadIdx.x; asm volatile("" : "+v"(tid_));
    const int tid = tid_, wid = __builtin_amdgcn_readfirstlane(tid >> 6), lane = tid & 63, l31 = lane & 31, hh = lane >> 5;
    for (int it = vcu; it < 256; it += G) {
        const int bh = it >> 2, es = it & 3, b = bh >> 3, h = bh & 7;
        const size_t row00 = (size_t)b * SEQ;
        f32x16 st;
#pragma unroll
        for (int r = 0; r < 16; ++r) st[r] = 0.f;
        u32x4 rqA[2], rkA[2], rhA[2], rvA, rdA;
        const int p0 = tid, p1 = tid + 512;
        const bf16_t* qsrc0 = QT + (row00 + (p0 >> 4)) * 1024 + h * 128 + (p0 & 15) * 8; const bf16_t* qsrc1 = QT + (row00 + (p1 >> 4)) * 1024 + h * 128 + (p1 & 15) * 8;
        const bf16_t* ksrc0 = KT + (row00 + (p0 >> 4)) * 1024 + h * 128 + (p0 & 15) * 8; const bf16_t* ksrc1 = KT + (row00 + (p1 >> 4)) * 1024 + h * 128 + (p1 & 15) * 8;
        const int qd0 = (p0 >> 4) * HS_QP + (p0 & 15) * 16, qd1 = (p1 >> 4) * HS_QP + (p1 & 15) * 16;
        const bf16_t* hsrc0 = KHT + (((size_t)b * 128 * 8 + h) * 128 + (p0 >> 3)) * 64 + (p0 & 7) * 8; const bf16_t* hsrc1 = KHT + (((size_t)b * 128 * 8 + h) * 128 + (p1 >> 3)) * 64 + (p1 & 7) * 8;
        const int hd0 = HS_KHT + (p0 >> 3) * HS_P + (p0 & 7) * 16, hd1 = HS_KHT + (p1 >> 3) * HS_P + (p1 & 7) * 16;
        const int tv = tid & 255;
        const bf16_t* vsrc = HVT + ((row00 >> 6) * 1024 + h * 128 + es * 32 + (tv >> 3)) * 64 + (tv & 7) * 8; const int vd = HS_VT + (tv >> 3) * HS_P + (tv & 7) * 16;
        const int td = tid & 31;
        const float* dsrc = DEC + (size_t)b * 128 * 1024 + h * 128 + td * 4; const int dd = HS_DEC + td * 16;
#define HS_LOAD(c, X) do { rq##X[0] = *(const u32x4*)(qsrc0 + (size_t)(c) * 65536); rq##X[1] = *(const u32x4*)(qsrc1 + (size_t)(c) * 65536); \
        rk##X[0] = *(const u32x4*)(ksrc0 + (size_t)(c) * 65536); rk##X[1] = *(const u32x4*)(ksrc1 + (size_t)(c) * 65536); \
        rh##X[0] = *(const u32x4*)(hsrc0 + (size_t)(c) * 65536); rh##X[1] = *(const u32x4*)(hsrc1 + (size_t)(c) * 65536); \
        if (tid < 256) rv##X = *(const u32x4*)(vsrc + (size_t)(c) * 65536); else if (tid < 288) rd##X = *(const u32x4*)(dsrc + (size_t)(c) * 1024); } while (0)
#define HS_STORE(buf, X) do { ldsp B_ = lds + (buf) * HS_BUF; *(LAS u32x4*)(B_ + HS_QT + qd0) = rq##X[0]; *(LAS u32x4*)(B_ + HS_QT + qd1) = rq##X[1]; \
        *(LAS u32x4*)(B_ + HS_KT + qd0) = rk##X[0]; *(LAS u32x4*)(B_ + HS_KT + qd1) = rk##X[1]; lds_w8x2(B_ + hd0, rh##X[0]); lds_w8x2(B_ + hd1, rh##X[1]); \
        if (tid < 256) lds_w8x2(B_ + vd, rv##X); else if (tid < 288) *(LAS u32x4*)(B_ + dd) = rd##X; } while (0)
        HS_LOAD(0, A); HS_STORE(0, A); __syncthreads();
        const int tb = wid >> 2, db = wid & 3;
        LAS float* red = (LAS float*)(lds + HS_RED);
#pragma unroll 1
        for (int c2 = 0; c2 < 128; c2 += 2) {
            { const int c = c2, buf = 0;
              HS_LOAD(c + 1, A);
            ldsp Lb = lds + buf * HS_BUF;
            ldsp qb_ = Lb + HS_QT + (tb * 32 + l31) * HS_QP + db * 64 + hh * 16; ldsp kb_ = Lb + HS_KT + l31 * HS_QP + db * 64 + hh * 16;
            ldsp qr_ = Lb + HS_QT + (tb * 32 + l31) * HS_QP + 8 * hh + db * 64; ldsp vr_ = Lb + HS_VT + l31 * HS_P + 8 * hh;
            const bf16x8 qv0 = *(const LAS bf16x8*)(qb_), qv1 = *(const LAS bf16x8*)(qb_ + 32), k00 = *(const LAS bf16x8*)(kb_), k01 = *(const LAS bf16x8*)(kb_ + 32);
            const bf16x8 qa0 = lds_8x2(qr_, 16), qa1 = lds_8x2(qr_ + 32, 16), v00 = lds_8x2(vr_, 16), v01 = lds_8x2(vr_ + 32, 16);
            bf16x8 k10 = k00, k11 = k01, v10 = v00, v11 = v01;
            if (tb == 1) { k10 = *(const LAS bf16x8*)(kb_ + 32 * HS_QP); k11 = *(const LAS bf16x8*)(kb_ + 32 * HS_QP + 32); v10 = lds_8x2(vr_ + 64, 16); v11 = lds_8x2(vr_ + 96, 16); }
            __builtin_amdgcn_sched_barrier(0);
            f32x16 a0, o;
#pragma unroll
            for (int r = 0; r < 16; ++r) { a0[r] = 0.f; o[r] = 0.f; }
            a0 = MFMA32(k00, qv0, a0); a0 = MFMA32(k01, qv1, a0);
            o = MFMA32(qa0, pack8(st, 0), o); o = MFMA32(qa1, pack8(st, 1), o);
            { const float z0 = (tb == 0) ? 0.f : 1.f;
#pragma unroll
              for (int r = 0; r < 16; ++r) a0[r] *= (crow(r, hh) <= l31) ? 1.f : z0; }
            o = MFMA32(pack8(a0, 0), v00, o); o = MFMA32(pack8(a0, 1), v01, o);
            if (tb == 1) {
#pragma unroll
                for (int r = 0; r < 16; ++r) a0[r] = 0.f;
                a0 = MFMA32(k10, qv0, a0); a0 = MFMA32(k11, qv1, a0);
#pragma unroll
                for (int r = 0; r < 16; ++r) a0[r] *= (crow(r, hh) <= l31) ? 1.f : 0.f;
                o = MFMA32(pack8(a0, 0), v10, o); o = MFMA32(pack8(a0, 1), v11, o);
            }
            bf16x8 ka[4], vb[4];
#pragma unroll
            for (int ks = 0; ks < 4; ++ks) { ka[ks] = lds_8x2(Lb + HS_KHT + (db * 32 + l31) * HS_P + (ks * 16 + hh * 8) * 2, 8); vb[ks] = lds_8x2(Lb + HS_VT + l31 * HS_P + (ks * 16 + hh * 8) * 2, 8); }
            __builtin_amdgcn_sched_barrier(0);
            __syncthreads();
#pragma unroll
            for (int r = 0; r < 16; ++r) red[wid * 1024 + r * 64 + lane] = o[r];
#pragma unroll
            for (int r = 0; r < 16; ++r) st[r] *= *(const LAS float*)(Lb + HS_DEC + (db * 32 + crow(r, hh)) * 4);
#pragma unroll
            for (int ks = 0; ks < 4; ++ks) st = MFMA32(ka[ks], vb[ks], st);
            HS_STORE(1, A);
            __syncthreads();
            { bf16_t* op = HO + (row00 + (size_t)c * 64 + tb * 32 + 8 * db + 4 * hh) * 1024 + h * 128 + es * 32 + l31;
#pragma unroll
              for (int i = 0; i < 4; ++i) { const int ro = (4 * db + i) * 64 + lane; const float v = (red[(tb * 4 + 0) * 1024 + ro] + red[(tb * 4 + 1) * 1024 + ro]) + (red[(tb * 4 + 2) * 1024 + ro] + red[(tb * 4 + 3) * 1024 + ro]);
                  op[(size_t)i * 1024] = f2bf(v); } }
            }
            { const int c = c2 + 1, buf = 1;
              if (c + 1 < 128) HS_LOAD(c + 1, A);
            ldsp Lb = lds + buf * HS_BUF;
            ldsp qb_ = Lb + HS_QT + (tb * 32 + l31) * HS_QP + db * 64 + hh * 16; ldsp kb_ = Lb + HS_KT + l31 * HS_QP + db * 64 + hh * 16;
            ldsp qr_ = Lb + HS_QT + (tb * 32 + l31) * HS_QP + 8 * hh + db * 64; ldsp vr_ = Lb + HS_VT + l31 * HS_P + 8 * hh;
            const bf16x8 qv0 = *(const LAS bf16x8*)(qb_), qv1 = *(const LAS bf16x8*)(qb_ + 32), k00 = *(const LAS bf16x8*)(kb_), k01 = *(const LAS bf16x8*)(kb_ + 32);
            const bf16x8 qa0 = lds_8x2(qr_, 16), qa1 = lds_8x2(qr_ + 32, 16), v00 = lds_8x2(vr_, 16), v01 = lds_8x2(vr_ + 32, 16);
            bf16x8 k10 = k00, k11 = k01, v10 = v00, v11 = v01;
            if (tb == 1) { k10 = *(const LAS bf16x8*)(kb_ + 32 * HS_QP); k11 = *(const LAS bf16x8*)(kb_ + 32 * HS_QP + 32); v10 = lds_8x2(vr_ + 64, 16); v11 = lds_8x2(vr_ + 96, 16); }
            __builtin_amdgcn_sched_barrier(0);
            f32x16 a0, o;
#pragma unroll
            for (int r = 0; r < 16; ++r) { a0[r] = 0.f; o[r] = 0.f; }
            a0 = MFMA32(k00, qv0, a0); a0 = MFMA32(k01, qv1, a0);
            o = MFMA32(qa0, pack8(st, 0), o); o = MFMA32(qa1, pack8(st, 1), o);
            { const float z0 = (tb == 0) ? 0.f : 1.f;
#pragma unroll
              for (int r = 0; r < 16; ++r) a0[r] *= (crow(r, hh) <= l31) ? 1.f : z0; }
            o = MFMA32(pack8(a0, 0), v00, o); o = MFMA32(pack8(a0, 1), v01, o);
            if (tb == 1) {
#pragma unroll
                for (int r = 0; r < 16; ++r) a0[r] = 0.f;
                a0 = MFMA32(k10, qv0, a0); a0 = MFMA32(k11, qv1, a0);
#pragma unroll
                for (int r = 0; r < 16; ++r) a0[r] *= (crow(r, hh) <= l31) ? 1.f : 0.f;
                o = MFMA32(pack8(a0, 0), v10, o); o = MFMA32(pack8(a0, 1), v11, o);
            }
            bf16x8 ka[4], vb[4];
#pragma unroll
            for (int ks = 0; ks < 4; ++ks) { ka[ks] = lds_8x2(Lb + HS_KHT + (db * 32 + l31) * HS_P + (ks * 16 + hh * 8) * 2, 8); vb[ks] = lds_8x2(Lb + HS_VT + l31 * HS_P + (ks * 16 + hh * 8) * 2, 8); }
            __builtin_amdgcn_sched_barrier(0);
            __syncthreads();
#pragma unroll
            for (int r = 0; r < 16; ++r) red[wid * 1024 + r * 64 + lane] = o[r];
#pragma unroll
            for (int r = 0; r < 16; ++r) st[r] *= *(const LAS float*)(Lb + HS_DEC + (db * 32 + crow(r, hh)) * 4);
#pragma unroll
            for (int ks = 0; ks < 4; ++ks) st = MFMA32(ka[ks], vb[ks], st);
            if (c + 1 < 128) HS_STORE(0, A);
            __syncthreads();
            { bf16_t* op = HO + (row00 + (size_t)c * 64 + tb * 32 + 8 * db + 4 * hh) * 1024 + h * 128 + es * 32 + l31;
#pragma unroll
              for (int i = 0; i < 4; ++i) { const int ro = (4 * db + i) * 64 + lane; const float v = (red[(tb * 4 + 0) * 1024 + ro] + red[(tb * 4 + 1) * 1024 + ro]) + (red[(tb * 4 + 2) * 1024 + ro] + red[(tb * 4 + 3) * 1024 + ro]);
                  op[(size_t)i * 1024] = f2bf(v); } }
            }
        }
#undef HS_LOAD
#undef HS_STORE
    }
}
DI void hgrn_norm(const bf16_t* HO, const bf16_t* HG, const float* gn, bf16_t* HA, int gw, int NGW, int lane) {
    float gv[16];
#pragma unroll
    for (int j = 0; j < 16; ++j) gv[j] = gn[16 * lane + j];
    for (int row = gw; row < MTOK; row += 4 * NGW) {
        u32x4 a[4][2], g[4][2];
#pragma unroll
        for (int k = 0; k < 4; ++k) { const int rr = row + k * NGW; if (rr < MTOK) { const size_t idx = (size_t)rr * 1024 + 16 * lane;
            a[k][0] = *(const u32x4*)(HO + idx); a[k][1] = *(const u32x4*)(HO + idx + 8); g[k][0] = *(const u32x4*)(HG + idx); g[k][1] = *(const u32x4*)(HG + idx + 8); } }
#pragma unroll
        for (int k = 0; k < 4; ++k) { const int rr = row + k * NGW; if (rr < MTOK) { const size_t idx = (size_t)rr * 1024 + 16 * lane;
            f32x4 v[4], gg[4]; unpack8(a[k][0], v[0], v[1]); unpack8(a[k][1], v[2], v[3]); unpack8(g[k][0], gg[0], gg[1]); unpack8(g[k][1], gg[2], gg[3]);
            float ss = 0.f;
#pragma unroll
            for (int q = 0; q < 4; ++q) ss += (v[q][0] * v[q][0] + v[q][1] * v[q][1]) + (v[q][2] * v[q][2] + v[q][3] * v[q][3]);
            ss += __shfl_xor(ss, 1); ss += __shfl_xor(ss, 2); ss += __shfl_xor(ss, 4);
            const float rstd = rsqrtf(ss * (1.0f / 128.0f) + RMS_EPS);
            f32x4 o[4];
#pragma unroll
            for (int q = 0; q < 4; ++q)
#pragma unroll
                for (int j = 0; j < 4; ++j) o[q][j] = v[q][j] * rstd * gv[4 * q + j] * gg[q][j];
            *(u32x4*)(HA + idx) = pk8(o[0], o[1]); *(u32x4*)(HA + idx + 8) = pk8(o[2], o[3]); } }
    }
}
#define XB_TMO      128
#define XB_XCNT(j)  (256  + 64 * (j))
#define XB_XSUB(j)  (1280 + 64 * (j))
#define XB_XGEN(j)  (2304 + 64 * (j))
#define XB_TOP      3328
#define XB_TOPGEN   3392
#define XCD_BAR_WORDS 3456
#define XB_SPIN_CAP (1u << 18)

__device__ __forceinline__ unsigned xb_ld(unsigned* p)              { return __hip_atomic_load(p, __ATOMIC_RELAXED, __HIP_MEMORY_SCOPE_AGENT); }
__device__ __forceinline__ unsigned xb_add(unsigned* p, unsigned v) { return __hip_atomic_fetch_add(p, v, __ATOMIC_RELAXED, __HIP_MEMORY_SCOPE_AGENT); }
__device__ __forceinline__ unsigned xb_xcc_id() { return (unsigned)__builtin_amdgcn_s_getreg((3 << 11) | 20) & 0xFu; }
#define XB_SPIN(cond, bar) do { unsigned _sp = 0; while (cond) { __builtin_amdgcn_s_sleep(1); \
    if ((++_sp & 255u) == 0u) { if (xb_ld(&(bar)[XB_TMO])) break; if (_sp > XB_SPIN_CAP) { atomicAdd(&(bar)[XB_TMO], 1u); break; } } } } while (0)

struct XcdBarrier {
    unsigned* bar; unsigned x;
    volatile LAS unsigned* st;
};

__device__ __forceinline__ XcdBarrier xcd_barrier_post(unsigned* bar, volatile LAS unsigned* st) {
    XcdBarrier b; b.bar = bar; b.x = xb_xcc_id(); b.st = st;
    if (threadIdx.x == 0) (void)xb_add(&bar[XB_XCNT(b.x)], 1u);
    return b;
}
__device__ __forceinline__ void xcd_barrier_complete(unsigned* bar, unsigned x, unsigned& nloc, unsigned& nx) {
    const unsigned G = gridDim.x * gridDim.y * gridDim.z;
    unsigned sum, cnt, mine, sp = 0u;
    for (;;) {
        sum = 0u; cnt = 0u; mine = 0u;
#pragma unroll
        for (unsigned j = 0; j < 16; ++j) { const unsigned c = xb_ld(&bar[XB_XCNT(j)]); sum += c; cnt += (c > 0u) ? 1u : 0u; mine = (j == x) ? c : mine; }
        if (sum == G) break;
        __builtin_amdgcn_s_sleep(1);
        if ((++sp & 255u) == 0u) { if (xb_ld(&bar[XB_TMO])) break; if (sp > XB_SPIN_CAP) { atomicAdd(&bar[XB_TMO], 1u); break; } }
    }
    nloc = mine > 0u ? mine : 1u; nx = cnt > 0u ? cnt : 1u;
}

__device__ __forceinline__ void xcd_barrier(const XcdBarrier& b) {
    asm volatile("s_waitcnt vmcnt(0)" ::: "memory");
    __syncthreads();
    if (threadIdx.x == 0) {
        unsigned* bar = b.bar;
        __builtin_amdgcn_s_waitcnt(0);
        unsigned nloc = b.st[0], nx = b.st[1];
        if (nloc == 0u) { xcd_barrier_complete(bar, b.x, nloc, nx); b.st[0] = nloc; b.st[1] = nx; }
        const unsigned old = xb_add(&bar[XB_XSUB(b.x)], 1u);
        const unsigned gen = old / nloc;
        if (old + 1u == (gen + 1u) * nloc) {
            __builtin_amdgcn_fence(__ATOMIC_RELEASE, "agent");
            asm volatile("s_waitcnt vmcnt(0)" ::: "memory");
            const unsigned og = xb_add(&bar[XB_TOP], 1u);
            const unsigned tg = og / nx;
            if (og + 1u == (tg + 1u) * nx) xb_add(&bar[XB_TOPGEN], 1u);
            else XB_SPIN(xb_ld(&bar[XB_TOPGEN]) == tg, bar);
            __builtin_amdgcn_fence(__ATOMIC_ACQUIRE, "agent");
            xb_add(&bar[XB_XGEN(b.x)], 1u);
            asm volatile("s_waitcnt vmcnt(0)" ::: "memory");
        } else {
            XB_SPIN(xb_ld(&bar[XB_XGEN(b.x)]) == gen, bar);
            __builtin_amdgcn_fence(__ATOMIC_ACQUIRE, "agent");
            asm volatile("s_waitcnt vmcnt(0)" ::: "memory");
        }
    }
    __syncthreads();
}

struct Args { const void* in[21]; float* out; unsigned char* ws; int ph_lo, ph_hi; };
constexpr int N_PHASES = 20;

template <class Epi> DI void run_gemm(ldsp lds, const bf16_t* A, const bf16_t* Bt, int M, int N, int K, const Epi& E) {
    asm volatile("" : "+s"(M), "+s"(N), "+s"(K));
    pg8::Gemm g{A, Bt, M, N, K}; pg8::StaticOrder S; S.init(M, N, (int)gridDim.x, (int)blockIdx.x);
    pg8::gemm_phase<Epi, pg8::StaticOrder, true, true>(lds, g, S, E);
}

__global__ void __launch_bounds__(512, 2) mk_fwd(Args args) {
    extern __shared__ __attribute__((aligned(16))) unsigned char lds_raw[];
    ldsp lds = (ldsp)lds_raw;
    cg::grid_group grid = cg::this_grid();
    const int tid = threadIdx.x, lane = tid & 63, wave = __builtin_amdgcn_readfirstlane(tid >> 6);
    const int G = gridDim.x, bx = blockIdx.x, vcu = (G % 8 == 0) ? (bx % 8) * (G / 8) + bx / 8 : bx;
    const int gw = vcu * 8 + wave, NGW = G * 8;
    const size_t gt = (size_t)bx * 512 + tid, NGT = (size_t)G * 512;
    const int lo = args.ph_lo, hi = args.ph_hi;
    volatile LAS unsigned* xst = (volatile LAS unsigned*)(lds + 147456);
    if (tid < 2) xst[tid] = 0u;
    __syncthreads();
    XcdBarrier xbar; xbar.bar = (unsigned*)(args.ws + 512 * 1024); xbar.x = 0; xbar.st = xst;
    unsigned char* ws = args.ws; unsigned char* dout = (unsigned char*)args.out;
    const float* x_in = (const float*)args.in[0]; const float* p_in = (const float*)args.in[1]; const int* pos = (const int*)args.in[2];
    bf16_t* WB = (bf16_t*)(ws + WS_W);
    bf16_t* PB = (bf16_t*)(ws + WS_PB); bf16_t* XB = (bf16_t*)(ws + WS_XB); float* XF = (float*)(ws + WS_XF); bf16_t* XB2 = (bf16_t*)(ws + WS_XB2);
    float* YW = (float*)(ws + WS_Y); float* YD = (float*)dout; bf16_t* PP = (bf16_t*)(ws + WS_PP); bf16_t* H = (bf16_t*)(ws + WS_H);
    bf16_t* Qb = (bf16_t*)(ws + WS_Q); bf16_t* DQ = (bf16_t*)(ws + WS_DQ); bf16_t* DKV = (bf16_t*)(ws + WS_DKV); bf16_t* KN = (bf16_t*)(ws + WS_KN); bf16_t* VT = (bf16_t*)(ws + WS_VT);
    bf16_t* Ob = (bf16_t*)(dout + DO_O); bf16_t* KR = (bf16_t*)(dout + DO_KR); float* SSQ = (float*)(dout + DO_SSQ);
    bf16_t* HQ = (bf16_t*)(ws + WS_HQ); float* LOGF = (float*)(ws + WS_LOGF); bf16_t* HK = (bf16_t*)(ws + WS_HK); bf16_t* HVT = (bf16_t*)(dout + DO_HVT); bf16_t* HG = (bf16_t*)(dout + DO_HG);
    bf16_t* KHT = (bf16_t*)(ws + WS_KHT); float* DEC = (float*)(ws + WS_DEC); bf16_t* HO = (bf16_t*)(ws + WS_HO); bf16_t* HA = (bf16_t*)(dout + DO_HA);
    f32x2v* ST1 = (f32x2v*)(ws + WS_ST1); f32x2v* ST2 = (f32x2v*)(ws + WS_ST2); float* CTLF = (float*)ws; float* PART = (float*)(ws + WS_PART);
    const float* lnmg = (const float*)args.in[15]; const float* lnmb = (const float*)args.in[16]; const float* lnfg = (const float*)args.in[17]; const float* lnfb = (const float*)args.in[18];
#ifndef SKIPMASK
#define SKIPMASK 0u
#endif
#define RUN(k) (lo <= (k) && (k) < hi && !((SKIPMASK >> (k)) & 1u))
#ifndef REPEATMASK
#define REPEATMASK 0u
#endif
#define REP(k) for (int rep_ = 0; rep_ < 1 + (int)((REPEATMASK >> (k)) & 1u); ++rep_)
#define RSYNC() do { if (rep_) grid.sync(); } while (0)
#define SEAM(k) do { if (RUN(k) && RUN((k) + 1)) { if ((k) == 0) grid.sync(); else xcd_barrier(xbar); } } while (0)

    if (RUN(0)) REP(0) { RSYNC();
        LAS float* scr = (LAS float*)(lds + wave * 16384);
        transpose_mat<MAT_DQKV>((const float*)args.in[3], 1024, 576, 768, WB + W_DQKV, nullptr, 1.f, scr, gw, NGW, lane);
        transpose_mat<MAT_UQ>((const float*)args.in[6], 256, 1536, 1536, WB + W_UQ, (const float*)args.in[4], QSCALE, scr, gw, NGW, lane);
        transpose_mat<MAT_UK>((const float*)args.in[7], 256, 2048, 1024, WB + W_UK, (const float*)args.in[5], 1.f, scr, gw, NGW, lane);
        transpose_mat<MAT_UV>((const float*)args.in[7], 256, 2048, 1024, WB + W_UV, (const float*)args.in[5], 1.f, scr, gw, NGW, lane);
        transpose_mat<MAT_ID>((const float*)args.in[8], 1024, 1024, 1024, WB + W_WO, nullptr, 1.f, scr, gw, NGW, lane);
        transpose_mat<MAT_HIN>((const float*)args.in[9], 1024, 4096, 4096, WB + W_HIN, nullptr, 1.f, scr, gw, NGW, lane);
        transpose_mat<MAT_ID>((const float*)args.in[12], 1024, 1024, 1024, WB + W_HO, nullptr, 1.f, scr, gw, NGW, lane);
        for (int i = 0; i < 2; ++i) {
            transpose_mat<MAT_FIN, true>((const float*)args.in[13] + (size_t)i * 1024 * 5632, 1024, 5632, 5632, WB + W_FIN + (size_t)i * 5632 * 1024, lnmg + i * 1024, 1.f, scr, gw, NGW, lane,
                                         lnmb + i * 1024, PART + P_FIN + (size_t)(i * 2 + 0) * 16 * 5632, PART + P_FIN + (size_t)(i * 2 + 1) * 16 * 5632);
            transpose_mat<MAT_ID>((const float*)args.in[14] + (size_t)i * 2816 * 1024, 2816, 1024, 1024, WB + W_FDN + (size_t)i * 1024 * 2816, nullptr, 1.f, scr, gw, NGW, lane);
            transpose_mat<MAT_ID>((const float*)args.in[19] + (size_t)i * 256 * 1024, 256, 1024, 1024, WB + W_PPJ + (size_t)i * 1024 * 256, nullptr, 1.f, scr, gw, NGW, lane);
            transpose_mat<MAT_ID, true>((const float*)args.in[20] + (size_t)i * 1024 * 1024, 1024, 1024, 1024, WB + W_PG + (size_t)i * 1024 * 1024, lnfg + i * 1024, 1.f, scr, gw, NGW, lane,
                                        lnfb + i * 1024, PART + P_PG + (size_t)(i * 2 + 0) * 16 * 1024, PART + P_PG + (size_t)(i * 2 + 1) * 16 * 1024);
        }
        cast_bf16(x_in, XB, (size_t)MTOK * 1024, gt, NGT);
        cast_bf16(p_in, PB, (size_t)2 * MTOK * 256, gt, NGT);
    }
    if (RUN(0) && bx == 0) { unsigned* bw = (unsigned*)(args.ws + 512 * 1024); for (int i = tid; i < 4096; i += 512) bw[i] = 0u; }
    SEAM(0);
    xbar = xcd_barrier_post((unsigned*)(args.ws + 512 * 1024), xst);
    if (RUN(1)) REP(1) { RSYNC();
        if (gt < 2 * (5632 + 1024)) {
            const int i = (int)gt; float c = 0.f, bsum = 0.f;
            if (i < 2 * 5632) { const int ly = i / 5632, n = i % 5632; const float* pc = PART + P_FIN + (size_t)(ly * 2) * 16 * 5632 + n; const float* pb = pc + 16 * 5632;
                for (int kb = 0; kb < 16; ++kb) { c += pc[kb * 5632]; bsum += pb[kb * 5632]; }
                CTLF[C_CSF + ly * 5632 + n] = c; CTLF[C_BWF + ly * 5632 + n] = bsum;
            } else { const int i2 = i - 2 * 5632, ly = i2 / 1024, n = i2 % 1024; const float* pc = PART + P_PG + (size_t)(ly * 2) * 16 * 1024 + n; const float* pb = pc + 16 * 1024;
                for (int kb = 0; kb < 16; ++kb) { c += pc[kb * 1024]; bsum += pb[kb * 1024]; }
                CTLF[C_CSG + ly * 1024 + n] = c; CTLF[C_BWG + ly * 1024 + n] = bsum; }
        }
        EpiDown E{DQ, DKV, KR, SSQ, pos}; run_gemm(lds, XB, WB + W_DQKV, MTOK, 768, 1024, E); }
    SEAM(1);
    if (RUN(2)) REP(2) { RSYNC();
#ifndef NO_P2A
        { EpiUQ E{Qb, SSQ, pos}; run_gemm(lds, DQ, WB + W_UQ, MTOK, 1536, 256, E); }
#endif
#ifndef NO_P2B
        { EpiUK E{KN, SSQ}; run_gemm(lds, DKV, WB + W_UK, MTOK, 1024, 256, E); }
#endif
#ifndef NO_P2C
        { EpiVT E{VT, SSQ}; run_gemm(lds, WB + W_UV, DKV, 1024, MTOK, 256, E); }
#endif
    }
    SEAM(2);
    if (RUN(3)) REP(3) { RSYNC(); attn_phase(lds, Qb, KN, KR, VT, Ob, vcu, G); }
    SEAM(3);
    if (RUN(4)) REP(4) { RSYNC(); EpiRes2<false, true> E{XB, nullptr, nullptr, nullptr, XB, ST1}; run_gemm(lds, Ob, WB + W_WO, MTOK, 1024, 1024, E); }
    SEAM(4);
    if (RUN(6)) REP(6) { RSYNC();
        { EpiSwigluLN E{H, ST1, CTLF + C_CSF, CTLF + C_BWF}; run_gemm(lds, XB, WB + W_FIN, MTOK, 5632, 1024, E); }
        { EpiBf16<false> E{PP, 1024}; run_gemm(lds, PB, WB + W_PPJ, MTOK, 1024, 256, E); }
    }
    SEAM(6);
    if (RUN(7)) REP(7) { RSYNC(); EpiRes2<true, true> E{XB, ST1, lnmg, lnmb, XB, ST2}; run_gemm(lds, H, WB + W_FDN, MTOK, 1024, 2816, E); }
    SEAM(7);
    if (RUN(9)) REP(9) { RSYNC(); EpiGateLN E{XB, ST2, lnfg, lnfb, CTLF + C_CSG, CTLF + C_BWG, PP, nullptr, XB2}; run_gemm(lds, XB, WB + W_PG, MTOK, 1024, 1024, E); }
    SEAM(9);
    if (RUN(10)) REP(10) { RSYNC();
        { EpiHin E{HQ, HK, KHT, DEC, HG, (const float*)args.in[10]}; run_gemm(lds, XB2, WB + W_HIN, MTOK, 3072, 1024, E); }
        { EpiBf16<true> E{HVT, 65536}; run_gemm(lds, WB + W_HIN + (size_t)3072 * 1024, XB2, 1024, MTOK, 1024, E); }
    }
    SEAM(10);
    if (RUN(12)) REP(12) { RSYNC(); hgrn_scan(lds, HQ, HK, KHT, HVT, DEC, HO, vcu, G); }
    SEAM(12);
    if (RUN(13)) REP(13) { RSYNC(); hgrn_norm(HO, HG, (const float*)args.in[11], HA, gw, NGW, lane); }
    SEAM(13);
    if (RUN(14)) REP(14) { RSYNC(); EpiRes2<false, true> E{XB2, nullptr, nullptr, nullptr, XB, ST1}; run_gemm(lds, HA, WB + W_HO, MTOK, 1024, 1024, E); }
    SEAM(14);
    if (RUN(16)) REP(16) { RSYNC();
        { EpiSwigluLN E{H, ST1, CTLF + C_CSF + 5632, CTLF + C_BWF + 5632}; run_gemm(lds, XB, WB + W_FIN + (size_t)5632 * 1024, MTOK, 5632, 1024, E); }
        { EpiBf16<false> E{PP, 1024}; run_gemm(lds, PB + (size_t)MTOK * 256, WB + W_PPJ + (size_t)1024 * 256, MTOK, 1024, 256, E); }
    }
    SEAM(16);
    if (RUN(17)) REP(17) { RSYNC(); EpiRes2<true, true> E{XB, ST1, lnmg + 1024, lnmb + 1024, XB, ST2}; run_gemm(lds, H, WB + W_FDN + (size_t)1024 * 2816, MTOK, 1024, 2816, E); }
    SEAM(17);
    if (RUN(19)) REP(19) { RSYNC(); EpiGateLN E{XB, ST2, lnfg + 1024, lnfb + 1024, CTLF + C_CSG + 1024, CTLF + C_BWG + 1024, PP, YD, nullptr}; run_gemm(lds, XB, WB + W_PG + (size_t)1024 * 1024, MTOK, 1024, 1024, E); }
#undef RUN
#undef SEAM
}

#ifndef MK_MULTI
#define MK_MULTI 0
#endif
extern "C" void kernel_launch(void* const* d_in, const int* in_sizes, int n_in, void* d_out, int out_size, void* d_ws, size_t ws_size, hipStream_t stream) {
    static int grid = 0;
    if (grid == 0) {
        int dev = 0, cus = 0, per_cu = 0;
        hipGetDevice(&dev);
        hipDeviceGetAttribute(&cus, hipDeviceAttributeMultiprocessorCount, dev);
        hipFuncSetAttribute((const void*)mk_fwd, hipFuncAttributeMaxDynamicSharedMemorySize, LDS_BYTES);
        hipOccupancyMaxActiveBlocksPerMultiprocessor(&per_cu, (const void*)mk_fwd, 512, LDS_BYTES);
        if (per_cu < 1) { fprintf(stderr, "kernel_launch: occupancy query says %d blocks per CU\n", per_cu); per_cu = 1; }
        (void)hipGetLastError();
        grid = cus * 1;
        if (n_in != 21 || ws_size < 1024 * MiB) fprintf(stderr, "kernel_launch: unexpected n_in %d / ws_size %zu\n", n_in, ws_size);
    }
    Args a{};
    for (int i = 0; i < 21; ++i) a.in[i] = d_in[i];
    a.out = (float*)d_out; a.ws = (unsigned char*)d_ws;
#if MK_MULTI
    for (int k = 0; k < N_PHASES; ++k) { a.ph_lo = k; a.ph_hi = k + 1; hipLaunchKernelGGL(mk_fwd, dim3(grid), dim3(512), LDS_BYTES, stream, a); }
#else
    a.ph_lo = 0; a.ph_hi = N_PHASES;
    void* kargs[] = {&a};
    hipError_t e = hipLaunchCooperativeKernel((const void*)mk_fwd, dim3(grid), dim3(512), kargs, LDS_BYTES, stream);
    if (e != hipSuccess) fprintf(stderr, "kernel_launch: cooperative launch failed: %s (grid %d)\n", hipGetErrorString(e), grid);
#endif
}
```
